# Optimizing an MI355X kernel written in HIP

```python
import math
import jax, jax.numpy as jnp
from jax import lax
import numpy as np


D_MODEL = 1024
BATCH = 8
SEQ = 2048
DEPTH = 2
DEC_BATCH = 32
DEC_SEQ = 8
PAST_LEN = 8192
PAGE_SIZE = 128

N_A_LAYERS = DEPTH // 2
N_B_LAYERS = DEPTH - N_A_LAYERS
EPS = 1e-6
FFN_DIM = 2688
GLA_HEADS = 4
GLA_DK = D_MODEL // 2 // GLA_HEADS
GLA_DV = D_MODEL // GLA_HEADS
GLA_RANK = 16
GLA_TAU = 16.0
GLA_CHUNK = 64
GLA_QK = GLA_HEADS * GLA_DK
GLA_V = GLA_HEADS * GLA_DV
GLA_IN = 2 * GLA_QK + GLA_V + GLA_RANK + GLA_V
HEAD_DIM = 64
N_KV_HEADS = 4
HEADS_PER_GROUP = 4
DIL_GROUPS = ((128, 1), (512, 4), (2048, 16))
N_GROUPS = len(DIL_GROUPS)
N_Q_HEADS = N_GROUPS * HEADS_PER_GROUP
MAX_WINDOW = max(w for w, _ in DIL_GROUPS)
Q_BLOCK = 128
ROPE_THETA = 10000.0

kernel_name = 'yoco_gla_dilated_window_decoder_step'


def rmsnorm(x, g):
    xf = x.astype(jnp.float32)
    y = xf * lax.rsqrt(jnp.mean(xf * xf, axis=-1, keepdims=True) + EPS)
    return (y * g.astype(jnp.float32)).astype(x.dtype)


def swiglu_ffn(x, w_in, w_out):
    g, u = jnp.split(x @ w_in, 2, axis=-1)
    return (jax.nn.silu(g) * u) @ w_out


def rope(x, pos):
    half = HEAD_DIM // 2
    inv = ROPE_THETA ** (-jnp.arange(half, dtype=jnp.float32) / half)
    ang = pos.astype(jnp.float32)[:, None] * inv[None, :]
    cos = jnp.cos(ang)[None, :, None, :]
    sin = jnp.sin(ang)[None, :, None, :]
    xf = x.astype(jnp.float32)
    x1, x2 = xf[..., :half], xf[..., half:]
    return jnp.concatenate([x1 * cos - x2 * sin, x1 * sin + x2 * cos], axis=-1).astype(x.dtype)


def gla_recurrence(q, k, v, log_a, s0):
    b, n = q.shape[:2]
    c = math.gcd(n, GLA_CHUNK)
    nc = n // c

    def to_chunks(t):
        return jnp.moveaxis(t.reshape(b, nc, c, *t.shape[2:]), 1, 0)

    causal = jnp.tril(jnp.ones((c, c), dtype=bool))

    def step(state, inp):
        qc, kc, vc, gc = inp
        qf, kf, vf = qc.astype(jnp.float32), kc.astype(jnp.float32), vc.astype(jnp.float32)
        cum = jnp.cumsum(gc.astype(jnp.float32), axis=1)
        diff = cum[:, :, None] - cum[:, None, :]
        decay = jnp.exp(jnp.where(causal[None, :, :, None, None], diff, -jnp.inf))
        attn = jnp.einsum('bihd,bjhd,bijhd->bhij', qf, kf, decay)
        o = (jnp.einsum('bhij,bjhv->bihv', attn, vf)
             + jnp.einsum('bihd,bhdv->bihv', qf * jnp.exp(cum), state))
        last = cum[:, -1]
        k_dec = kf * jnp.exp(last[:, None] - cum)
        state = jnp.exp(last)[..., None] * state + jnp.einsum('bjhd,bjhv->bhdv', k_dec, vf)
        return state, o

    s_fin, o = lax.scan(step, s0.astype(jnp.float32),
                        (to_chunks(q), to_chunks(k), to_chunks(v), to_chunks(log_a)))
    o = jnp.moveaxis(o, 0, 1).reshape(b, n, GLA_HEADS, GLA_DV)
    return o, s_fin


def gla_mixer(h, w_in, w_g2, b_g, out_norm, w_out, s0):
    b, n, _ = h.shape
    proj = h @ w_in
    q, k, v, g_lr, r = jnp.split(proj, [GLA_QK, 2 * GLA_QK, 2 * GLA_QK + GLA_V,
                                        2 * GLA_QK + GLA_V + GLA_RANK], axis=-1)
    q = q.reshape(b, n, GLA_HEADS, GLA_DK) * (GLA_DK ** -0.5)
    k = k.reshape(b, n, GLA_HEADS, GLA_DK)
    v = v.reshape(b, n, GLA_HEADS, GLA_DV)
    log_a = jax.nn.log_sigmoid((g_lr @ w_g2 + b_g).astype(jnp.float32)) / GLA_TAU
    log_a = log_a.reshape(b, n, GLA_HEADS, GLA_DK)
    o, s_fin = gla_recurrence(q, k, v, log_a, s0)
    o = rmsnorm(o, out_norm).reshape(b, n, GLA_V).astype(h.dtype)
    y = (o * jax.nn.silu(r)) @ w_out
    return y, s_fin.astype(h.dtype)


def shared_kv(x, kv_norm, kv_w, k_norm, pos):
    b, n, _ = x.shape
    k, v = jnp.split(rmsnorm(x, kv_norm) @ kv_w, 2, axis=-1)
    k = rope(rmsnorm(k.reshape(b, n, N_KV_HEADS, HEAD_DIM), k_norm), pos)
    v = v.reshape(b, n, N_KV_HEADS, HEAD_DIM)
    return k, v


def dilated_window_attention(q, k_src, v_src, n_pad):
    b, n = q.shape[:2]
    qb = math.gcd(n, Q_BLOCK)
    nb = n // qb
    scale = HEAD_DIM ** -0.5
    q_blocks = jnp.moveaxis(q.reshape(b, nb, qb, N_GROUPS, HEADS_PER_GROUP, HEAD_DIM), 1, 0)

    def block(args):
        qblk, start = args
        rows = MAX_WINDOW + start + jnp.arange(qb)
        outs, lses = [], []
        for g, (win, dil) in enumerate(DIL_GROUPS):
            nk = win // dil + 1
            idx = rows[:, None] - dil * jnp.arange(nk)[None, :]
            valid = idx >= n_pad
            kg = jnp.take(k_src, idx, axis=1).astype(jnp.float32)
            vg = jnp.take(v_src, idx, axis=1).astype(jnp.float32)
            s = jnp.einsum('bqjd,bqkjd->bqjk', qblk[:, :, g].astype(jnp.float32), kg) * scale
            s = jnp.where(valid[None, :, None, :], s, -jnp.inf)
            m = jnp.max(s, axis=-1, keepdims=True)
            p = jnp.exp(s - m)
            den = jnp.sum(p, axis=-1, keepdims=True)
            outs.append(jnp.einsum('bqjk,bqkjd->bqjd', p, vg) / den)
            lses.append((m + jnp.log(den))[..., 0])
        o = jnp.stack(outs, axis=2)
        w = jax.nn.softmax(jnp.stack(lses, axis=2), axis=2)
        return o * w[..., None]

    out = lax.map(block, (q_blocks, jnp.arange(nb, dtype=jnp.int32) * qb))
    return jnp.moveaxis(out, 0, 1).reshape(b, n, N_Q_HEADS * HEAD_DIM)


def setup_inputs(seed: int = 0) -> dict:
    key = jax.random.key(seed)
    ks = jax.random.split(key, 19)

    def nrm(k, shape, scale):
        return jax.random.normal(k, shape, jnp.float32) * scale

    win_len = min(MAX_WINDOW, PAST_LEN)
    return {
        'x_prompt': nrm(ks[0], (BATCH, SEQ, D_MODEL), 1.0),
        'x_sample': nrm(ks[1], (DEC_BATCH, DEC_SEQ, D_MODEL), 1.0),
        'state_gla': nrm(ks[2], (N_A_LAYERS, DEC_BATCH, GLA_HEADS, GLA_DK, GLA_DV), 0.5),
        'cache_k_win': nrm(ks[3], (DEC_BATCH, win_len, N_KV_HEADS, HEAD_DIM), 1.0),
        'cache_v_win': nrm(ks[4], (DEC_BATCH, win_len, N_KV_HEADS, HEAD_DIM), 1.0),
        'norm_gains': 1.0 + nrm(ks[5], (DEPTH, 3, D_MODEL), 0.05),
        'ffn_w_in': nrm(ks[6], (DEPTH, 2, D_MODEL, 2 * FFN_DIM), D_MODEL ** -0.5),
        'ffn_w_out': nrm(ks[7], (DEPTH, 2, FFN_DIM, D_MODEL), FFN_DIM ** -0.5),
        'gla_w_in': nrm(ks[8], (N_A_LAYERS, D_MODEL, GLA_IN), D_MODEL ** -0.5),
        'gla_w_gate2': nrm(ks[9], (N_A_LAYERS, GLA_RANK, GLA_QK), GLA_RANK ** -0.5),
        'gla_b_gate': 2.0 + nrm(ks[10], (N_A_LAYERS, GLA_QK), 0.5),
        'gla_out_norm': 1.0 + nrm(ks[11], (N_A_LAYERS, GLA_DV), 0.05),
        'gla_w_out': nrm(ks[12], (N_A_LAYERS, GLA_V, D_MODEL), GLA_V ** -0.5),
        'kv_norm': 1.0 + nrm(ks[13], (D_MODEL,), 0.05),
        'kv_w': nrm(ks[14], (D_MODEL, 2 * N_KV_HEADS * HEAD_DIM), D_MODEL ** -0.5),
        'k_norm': 1.0 + nrm(ks[15], (HEAD_DIM,), 0.05),
        'attn_w_q': nrm(ks[16], (N_B_LAYERS, D_MODEL, N_Q_HEADS * HEAD_DIM), D_MODEL ** -0.5),
        'q_norm': 1.0 + nrm(ks[17], (N_B_LAYERS, HEAD_DIM), 0.05),
        'attn_w_out': nrm(ks[18], (N_B_LAYERS, N_Q_HEADS * HEAD_DIM, D_MODEL), (N_Q_HEADS * HEAD_DIM) ** -0.5),
    }


def reference(x_prompt, x_sample, state_gla, cache_k_win, cache_v_win, norm_gains, ffn_w_in, ffn_w_out,
              gla_w_in, gla_w_gate2, gla_b_gate, gla_out_norm, gla_w_out, kv_norm, kv_w, k_norm,
              attn_w_q, q_norm, attn_w_out):

    def run(x, pos0, s0_all, k_buf, v_buf):
        b, n, _ = x.shape
        pos = pos0 + jnp.arange(n, dtype=jnp.int32)
        new_states = []
        k_new = v_new = k_src = v_src = None
        n_pad = 0
        for layer in range(DEPTH):
            x = x + 0.5 * swiglu_ffn(rmsnorm(x, norm_gains[layer, 0]), ffn_w_in[layer, 0], ffn_w_out[layer, 0])
            h = rmsnorm(x, norm_gains[layer, 1])
            if layer < N_A_LAYERS:
                y, s_fin = gla_mixer(h, gla_w_in[layer], gla_w_gate2[layer], gla_b_gate[layer],
                                     gla_out_norm[layer], gla_w_out[layer], s0_all[layer])
                new_states.append(s_fin)
            else:
                bl = layer - N_A_LAYERS
                q = (h @ attn_w_q[bl]).reshape(b, n, N_Q_HEADS, HEAD_DIM)
                q = rope(rmsnorm(q, q_norm[bl]), pos).reshape(b, n, N_GROUPS, HEADS_PER_GROUP, HEAD_DIM)
                y = dilated_window_attention(q, k_src, v_src, n_pad).astype(x.dtype) @ attn_w_out[bl]
            x = x + y
            x = x + 0.5 * swiglu_ffn(rmsnorm(x, norm_gains[layer, 2]), ffn_w_in[layer, 1], ffn_w_out[layer, 1])
            if layer == N_A_LAYERS - 1:
                k_new, v_new = shared_kv(x, kv_norm, kv_w, k_norm, pos)
                n_pad = MAX_WINDOW - k_buf.shape[1]
                pad = jnp.zeros((b, n_pad, N_KV_HEADS, HEAD_DIM), x.dtype)
                k_src = jnp.concatenate([pad, k_buf.astype(x.dtype), k_new], axis=1)
                v_src = jnp.concatenate([pad, v_buf.astype(x.dtype), v_new], axis=1)
        return x, jnp.stack(new_states, axis=0), k_new, v_new

    s0_prompt = jnp.zeros((N_A_LAYERS, BATCH, GLA_HEADS, GLA_DK, GLA_DV), x_prompt.dtype)
    empty = jnp.zeros((BATCH, 0, N_KV_HEADS, HEAD_DIM), x_prompt.dtype)
    y_prompt, state_gla_prompt, k_p, v_p = run(x_prompt, 0, s0_prompt, empty, empty)
    y_sample, state_gla_sample, k_s, v_s = run(x_sample, PAST_LEN, state_gla, cache_k_win, cache_v_win)
    keep = min(MAX_WINDOW, SEQ)
    k_win_prompt = k_p[:, SEQ - keep:]
    v_win_prompt = v_p[:, SEQ - keep:]
    return (y_prompt, y_sample, state_gla_prompt, state_gla_sample, k_win_prompt, v_win_prompt, k_s, v_s)
```

```cpp
#include <hip/hip_runtime.h>
#include <hip/hip_cooperative_groups.h>
#include <cstdio>
#include <cstdint>
namespace cg = cooperative_groups;
namespace pg8 {
#define PG8_LAS __attribute__((address_space(3)))
typedef unsigned short bf16_t;
typedef short bf16x8 __attribute__((ext_vector_type(8)));
typedef float f32x4 __attribute__((ext_vector_type(4)));
typedef unsigned u32x4 __attribute__((ext_vector_type(4)));
constexpr int BM = 256, BK = 64, HALF = 128, HTB = HALF * BK * 2  , STAGE_BYTES = 8 * HTB, NXCD = 8, WGM = 8;

__host__ __device__ __forceinline__ int lds_byte(int r, int c) { const int st = (r >> 4) * 2 + (c >> 5), rr = r & 15, cc = c & 31, ob = rr * 64 + cc * 2; return st * 1024 + (ob ^ (((ob >> 9) & 1) << 5)); }
__host__ __device__ __forceinline__ void stage_rc(int b, int& R, int& C) { const int st = b / 1024, sb = b % 1024, swz = sb ^ (((sb >> 9) & 1) << 5); R = (st >> 1) * 16 + swz / 64; C = (st & 1) * 32 + (swz % 64) / 2; }
__host__ __device__ __forceinline__ int perm32(int rho) { const int n = rho >> 4, i = rho & 15; return 8 * (i >> 2) + 4 * n + (i & 3); }

struct Unit { int pm, pn; };
struct Gemm { const bf16_t* A; const bf16_t* Bt; int M, N, K; };

struct StaticOrder {
    int nM, nN, nwg, G, c;
    __host__ __device__ void init(int M, int N, int G_, int c_) { nM = M / BM; nN = N / BM; nwg = nM * nN; G = G_; c = c_; }
    __host__ __device__ bool next(int i, Unit& u) const {
        const long L = (long)i * G + c; if (L >= nwg) return false;
        int wgid = (int)L; { const int q = nwg / NXCD, r = nwg % NXCD, xcd = wgid % NXCD, off = wgid / NXCD; wgid = (xcd < r ? xcd * (q + 1) : r * (q + 1) + (xcd - r) * q) + off; }
        const int nig = WGM * nN, gid = wgid / nig, fm = gid * WGM, gsz = (nM - fm) < WGM ? (nM - fm) : WGM;
        u.pm = fm + ((wgid % nig) % gsz); u.pn = (wgid % nig) / gsz; return true;
    }
    __device__ __forceinline__ void a_ready(const Unit&) const {}
    __device__ __forceinline__ void done(const Unit&) const {}
};

__device__ __forceinline__ unsigned cvt_pk_bf16(float lo, float hi) { unsigned r; asm volatile("v_cvt_pk_bf16_f32 %0, %1, %2" : "=v"(r) : "v"(lo), "v"(hi)); return r; }
typedef float f32x2 __attribute__((ext_vector_type(2)));
__device__ __forceinline__ f32x2 gelu_pk(f32x2 v) {
    const f32x2 av = __builtin_elementwise_abs(v), d = av * 0.2316418882f + 1.0f;
    f32x2 t; t.x = __builtin_amdgcn_rcpf(d.x); t.y = __builtin_amdgcn_rcpf(d.y);
    f32x2 q = t * 0.5307027145f + (-0.7265760135f); q = q * t + 0.7107068705f; q = q * t + (-0.142248368f); q = q * t + 0.127414796f; q = q * t;
    const f32x2 s = (v * v) * (-0.72134752044f);
    f32x2 e; e.x = __builtin_amdgcn_exp2f(s.x); e.y = __builtin_amdgcn_exp2f(s.y);
    const f32x2 m = v * (q * e), r = v - m;
    f32x2 o; o.x = v.x < 0.f ? m.x : r.x; o.y = v.y < 0.f ? m.y : r.y; return o;
}

template <int ACT  > struct EpiBf16 {
    static constexpr bool PERM = true, AFTER_DRAIN = false; static_assert(ACT == 0 || ACT == 1, "EpiBf16: ACT is 0 (none) or 1 (gelu_pk)");
    bf16_t* O; int ldc; const float* bias; int split_cols; size_t split_stride; float scale0;
    __device__ __forceinline__ void operator()(const f32x4 (&acc)[2][2][4][2], const Unit& u, int wr, int wc, int fr, int fq) const {
        const int row0 = u.pm * BM + wr * 64 + fr; int colt = u.pn * BM; bf16_t* base = O;
        float sc = 1.f; if (split_cols) { const int t = colt / split_cols; base += (size_t)t * split_stride; colt -= t * split_cols; if (t == 0) sc = scale0; }
        const int col0 = colt + wc * 32 + 8 * fq, bcol0 = u.pn * BM + wc * 32 + 8 * fq;
        f32x4 bv[2][2];
#pragma unroll
        for (int bj = 0; bj < 2; ++bj)
#pragma unroll
            for (int n = 0; n < 2; ++n) bv[bj][n] = bias ? *(const f32x4*)(bias + bcol0 + bj * HALF + 4 * n) : (f32x4){0.f, 0.f, 0.f, 0.f};
#pragma unroll
        for (int ai = 0; ai < 2; ++ai)
#pragma unroll
            for (int m = 0; m < 4; ++m) { bf16_t* rowp = base + (size_t)(row0 + ai * HALF + m * 16) * ldc + col0;
#pragma unroll
                for (int bj = 0; bj < 2; ++bj) { f32x4 v0 = acc[ai][bj][m][0] + bv[bj][0], v1 = acc[ai][bj][m][1] + bv[bj][1];
                    if (ACT == 1) { f32x2 a = gelu_pk((f32x2){v0[0], v0[1]}), b = gelu_pk((f32x2){v0[2], v0[3]}), c = gelu_pk((f32x2){v1[0], v1[1]}), d = gelu_pk((f32x2){v1[2], v1[3]});
                        v0 = (f32x4){a.x, a.y, b.x, b.y}; v1 = (f32x4){c.x, c.y, d.x, d.y}; }
                    v0 = v0 * sc; v1 = v1 * sc; u32x4 w; w.x = cvt_pk_bf16(v0[0], v0[1]); w.y = cvt_pk_bf16(v0[2], v0[3]); w.z = cvt_pk_bf16(v1[0], v1[1]); w.w = cvt_pk_bf16(v1[2], v1[3]);
                    *(u32x4*)(rowp + bj * HALF) = w; } }
    }
};

struct PanelStats {
    unsigned* xbuf;
    unsigned* cnt;
    unsigned* tmo;
    int ntn; float eps;
    unsigned code;
    __device__ __forceinline__ bool run(const f32x4 (&v)[2][2][4][2], const Unit& u, int wr, int wc, int fr, int fq, PG8_LAS unsigned char* lds, int wid, int lane) const {
        typedef float f32x2v __attribute__((ext_vector_type(2)));
        PG8_LAS f32x2v* P = (PG8_LAS f32x2v*)lds;
        PG8_LAS f32x2v* S = (PG8_LAS f32x2v*)(lds + 8192);
        PG8_LAS unsigned* flag = (PG8_LAS unsigned*)(lds + 8192 + 2048);
#pragma unroll
        for (int ai = 0; ai < 2; ++ai)
#pragma unroll
            for (int m = 0; m < 4; ++m) {
                float s = 0.f;
#pragma unroll
                for (int bj = 0; bj < 2; ++bj)
#pragma unroll
                    for (int n = 0; n < 2; ++n) { const f32x4 x = v[ai][bj][m][n]; s += (x[0] + x[1]) + (x[2] + x[3]); }
                s += __shfl_xor(s, 16); s += __shfl_xor(s, 32);
                const float mw = s * (1.0f / 64.0f); float q = 0.f;
#pragma unroll
                for (int bj = 0; bj < 2; ++bj)
#pragma unroll
                    for (int n = 0; n < 2; ++n) { const f32x4 d = v[ai][bj][m][n] - mw; q += (d[0] * d[0] + d[1] * d[1]) + (d[2] * d[2] + d[3] * d[3]); }
                q += __shfl_xor(q, 16); q += __shfl_xor(q, 32);
                if (fq == 0) P[(ai * HALF + wr * 64 + m * 16 + fr) * 4 + wc] = (f32x2v){mw, q};
            }
        asm volatile("s_waitcnt lgkmcnt(0)" ::: "memory"); __builtin_amdgcn_s_barrier(); asm volatile("" ::: "memory");
#if defined(BROKEN_EXCHANGE_NO_WAIT)
#warning BROKEN CONTROL BUILD: the row-statistics exchange does not wait; results are wrong by design
        if (blockIdx.x >= 64) { const long long t0_ = clock64(); while (clock64() - t0_ < 60000) __builtin_amdgcn_s_sleep(8); }
#endif
        const int row = wid * 32 + (lane & 31);
        if (lane < 32) {
            const f32x2v a = P[row * 4 + 0], b = P[row * 4 + 1], c = P[row * 4 + 2], d = P[row * 4 + 3];
            const float mt = (a.x + b.x + c.x + d.x) * 0.25f;
            const float da = a.x - mt, db = b.x - mt, dc = c.x - mt, dd = d.x - mt;
            const float m2 = (a.y + b.y) + (c.y + d.y) + 64.0f * ((da * da + db * db) + (dc * dc + dd * dd));
            unsigned long long* slot = (unsigned long long*)xbuf + ((size_t)(u.pm * BM + row) * 4 + u.pn);
            __hip_atomic_store(slot, ((unsigned long long)__float_as_uint(m2) << 32) | __float_as_uint(mt), __ATOMIC_RELAXED, __HIP_MEMORY_SCOPE_AGENT);
        }
        asm volatile("s_waitcnt vmcnt(0)" ::: "memory");
        if (lane == 0) __hip_atomic_fetch_add(cnt + 64 * u.pm, 1u, __ATOMIC_RELAXED, __HIP_MEMORY_SCOPE_AGENT);
        if (wid == 0) {
            bool dead = false; const unsigned long long t0 = __builtin_amdgcn_s_memrealtime(); const unsigned want = 8u * (unsigned)ntn;
            for (;;) {
#if defined(BROKEN_EXCHANGE_NO_WAIT)
                break;
#endif
                if ((unsigned)__builtin_amdgcn_readfirstlane(__hip_atomic_load(cnt + 64 * u.pm, __ATOMIC_RELAXED, __HIP_MEMORY_SCOPE_AGENT)) >= want) break;
                if (__builtin_amdgcn_s_memrealtime() - t0 > 2000000ull) {
                    if (lane == 0) { unsigned expect = 0u; __hip_atomic_compare_exchange_strong(tmo + 1, &expect, code | (unsigned)(u.pm & 0xff), __ATOMIC_RELAXED, __ATOMIC_RELAXED, __HIP_MEMORY_SCOPE_AGENT);
                                     __hip_atomic_store(tmo, 1u, __ATOMIC_RELAXED, __HIP_MEMORY_SCOPE_AGENT); }
                    dead = true; break; }
                __builtin_amdgcn_s_sleep(2);
            }
            __builtin_amdgcn_fence(__ATOMIC_ACQUIRE, "agent");
            if (lane == 0) flag[0] = dead ? 1u : 0u;
        }
        asm volatile("s_waitcnt vmcnt(0) lgkmcnt(0)" ::: "memory"); __builtin_amdgcn_s_barrier(); asm volatile("" ::: "memory");
        const bool bad = flag[0] != 0u;
        if (lane < 32) {
            const unsigned long long* slot = (const unsigned long long*)xbuf + (size_t)(u.pm * BM + row) * 4; float mt[4], m2[4]; float ms = 0.f;
#pragma unroll
            for (int t = 0; t < 4; ++t) { if (t < ntn) { const unsigned long long w = __hip_atomic_load(slot + t, __ATOMIC_RELAXED, __HIP_MEMORY_SCOPE_AGENT); mt[t] = __uint_as_float((unsigned)w); m2[t] = __uint_as_float((unsigned)(w >> 32)); } else { mt[t] = 0.f; m2[t] = 0.f; } ms += mt[t]; }
            const float mean = ms / (float)ntn; float q = 0.f;
#pragma unroll
            for (int t = 0; t < 4; ++t) if (t < ntn) { const float dm = mt[t] - mean; q += m2[t] + 256.0f * dm * dm; }
            S[row] = (f32x2v){mean, 1.0f / sqrtf(q / (256.0f * (float)ntn) + eps)};
        }
        asm volatile("s_waitcnt lgkmcnt(0)" ::: "memory"); __builtin_amdgcn_s_barrier(); asm volatile("" ::: "memory");
        return bad;
    }
};
struct EpiLnRes {
    static constexpr bool PERM = false, AFTER_DRAIN = true;
    const float* base; float* out; int ldc; const float* bias; PanelStats st; unsigned poison;
    __device__ __forceinline__ void fused(f32x4 (&acc)[2][2][4][2], const Unit& u, int wr, int wc, int fr, int fq, PG8_LAS unsigned char* lds, int wid, int lane) const {
        typedef float f32x2v __attribute__((ext_vector_type(2)));
        const PG8_LAS f32x2v* S = (const PG8_LAS f32x2v*)(lds + 8192);
        const int col0 = u.pn * BM + wc * 32 + 4 * fq;
#pragma unroll
        for (int bj = 0; bj < 2; ++bj)
#pragma unroll
            for (int n = 0; n < 2; ++n) { const f32x4 bv = bias ? *(const f32x4*)(bias + col0 + bj * HALF + n * 16) : (f32x4){0.f, 0.f, 0.f, 0.f};
#pragma unroll
                for (int ai = 0; ai < 2; ++ai)
#pragma unroll
                    for (int m = 0; m < 4; ++m) acc[ai][bj][m][n] += bv; }
        f32x4 pre[4][2][2];
#pragma unroll
        for (int m = 0; m < 4; ++m) { const size_t off = (size_t)(u.pm * BM + wr * 64 + m * 16 + fr) * ldc + col0;
#pragma unroll
            for (int bj = 0; bj < 2; ++bj)
#pragma unroll
                for (int n = 0; n < 2; ++n) pre[m][bj][n] = *(const f32x4*)(base + off + bj * HALF + n * 16); }
        const bool bad = st.run(acc, u, wr, wc, fr, fq, lds, wid, lane) || poison != 0u;
        const float qnan = __builtin_nanf("");
#pragma unroll
        for (int ai = 0; ai < 2; ++ai)
#pragma unroll
            for (int m = 0; m < 4; ++m) { const int r = ai * HALF + wr * 64 + m * 16 + fr; const f32x2v sr = S[r]; const size_t off = (size_t)(u.pm * BM + r) * ldc + col0;
#pragma unroll
                for (int bj = 0; bj < 2; ++bj)
#pragma unroll
                    for (int n = 0; n < 2; ++n) { const f32x4 bs = ai == 0 ? pre[m][bj][n] : *(const f32x4*)(base + off + bj * HALF + n * 16); f32x4 o = bs + (acc[ai][bj][m][n] - sr.x) * sr.y;
                        if (bad) o = (f32x4){qnan, qnan, qnan, qnan}; *(f32x4*)(out + off + bj * HALF + n * 16) = o; }
                if (m & 1) asm volatile("" ::: "memory"); }
    }
};
struct EpiLnResLn {
    static constexpr bool PERM = false, AFTER_DRAIN = true;
    const float* base; float* out; bf16_t* xn; int ldc; const float* bias; PanelStats st1, st2; unsigned poison;
    __device__ __forceinline__ void fused(f32x4 (&acc)[2][2][4][2], const Unit& u, int wr, int wc, int fr, int fq, PG8_LAS unsigned char* lds, int wid, int lane) const {
        typedef float f32x2v __attribute__((ext_vector_type(2))); typedef unsigned u32x2v __attribute__((ext_vector_type(2)));
        const PG8_LAS f32x2v* S = (const PG8_LAS f32x2v*)(lds + 8192);
        const int col0 = u.pn * BM + wc * 32 + 4 * fq;
#pragma unroll
        for (int bj = 0; bj < 2; ++bj)
#pragma unroll
            for (int n = 0; n < 2; ++n) { const f32x4 bv = bias ? *(const f32x4*)(bias + col0 + bj * HALF + n * 16) : (f32x4){0.f, 0.f, 0.f, 0.f};
#pragma unroll
                for (int ai = 0; ai < 2; ++ai)
#pragma unroll
                    for (int m = 0; m < 4; ++m) acc[ai][bj][m][n] += bv; }
        bool bad = st1.run(acc, u, wr, wc, fr, fq, lds, wid, lane) || poison != 0u;
        const float qnan = __builtin_nanf("");
#pragma unroll
        for (int ai = 0; ai < 2; ++ai)
#pragma unroll
            for (int m = 0; m < 4; ++m) { const int r = ai * HALF + wr * 64 + m * 16 + fr; const f32x2v sr = S[r]; const size_t off = (size_t)(u.pm * BM + r) * ldc + col0;
#pragma unroll
                for (int bj = 0; bj < 2; ++bj)
#pragma unroll
                    for (int n = 0; n < 2; ++n) { const f32x4 bs = *(const f32x4*)(base + off + bj * HALF + n * 16); acc[ai][bj][m][n] = bs + (acc[ai][bj][m][n] - sr.x) * sr.y; }
                asm volatile("" : "+v"(acc[ai][0][m][0]), "+v"(acc[ai][0][m][1]), "+v"(acc[ai][1][m][0]), "+v"(acc[ai][1][m][1]));
                if (m & 1) asm volatile("" ::: "memory"); }
        const bool bad1 = bad;
        bad = st2.run(acc, u, wr, wc, fr, fq, lds, wid, lane) || bad;
#pragma unroll
        for (int ai = 0; ai < 2; ++ai)
#pragma unroll
            for (int m = 0; m < 4; ++m) { const int r = ai * HALF + wr * 64 + m * 16 + fr; const f32x2v sr = S[r]; const size_t off = (size_t)(u.pm * BM + r) * ldc + col0;
#pragma unroll
                for (int bj = 0; bj < 2; ++bj)
#pragma unroll
                    for (int n = 0; n < 2; ++n) { const f32x4 x1 = acc[ai][bj][m][n]; *(f32x4*)(out + off + bj * HALF + n * 16) = bad1 ? (f32x4){qnan, qnan, qnan, qnan} : x1;
                        const f32x4 o = (x1 - sr.x) * sr.y; u32x2v w; w.x = cvt_pk_bf16(o[0], o[1]); w.y = cvt_pk_bf16(o[2], o[3]);
                        if (bad) { w.x = 0x7fc07fc0u; w.y = 0x7fc07fc0u; } *(u32x2v*)(xn + off + bj * HALF + n * 16) = w; }
                asm volatile("" ::: "memory"); }
    }
};

template <class Epi, class Sched, bool ALIGN_EPI = false, bool SP2 = false>
__device__ __forceinline__ void gemm_phase(PG8_LAS unsigned char* lds, const Gemm g, const Sched& S, const Epi& E) {
    const int tid = threadIdx.x, wid = __builtin_amdgcn_readfirstlane(tid >> 6), lane = tid & 63, wr = wid >> 2, wc = wid & 3, fr = lane & 15, fq = lane >> 4;
    const int K = g.K, nt = K / BK;
    unsigned voffA[2], voffB[2];
#pragma unroll
    for (int i = 0; i < 2; ++i) { int R, C; stage_rc(tid * 16 + i * 8192, R, C); const int Rb = Epi::PERM ? ((R & ~31) + perm32(R & 31)) : R;
        voffA[i] = (unsigned)(R * K + C) * 2u; voffB[i] = (unsigned)(Rb * K + C) * 2u; }
    const size_t kstep = (size_t)(BK * 2);
    const size_t hstep = (size_t)HALF * K * 2;
    const size_t tstep = 2 * hstep;
    const unsigned ldsw = (unsigned)wid * 1024u;
    const int aoff = lds_byte(wr * 64 + fr, fq * 8), boff = lds_byte(wc * 32 + fr, fq * 8);
#define PG8_SA(b, h) (((b) * 2 + (h)) * HTB)
#define PG8_SB(b, h) ((4 + (b) * 2 + (h)) * HTB)
#define PG8_STAGE(bufoff, gbase, voff) do { _Pragma("unroll") for (int _i = 0; _i < 2; ++_i) \
        __builtin_amdgcn_global_load_lds((const unsigned*)((const char*)(gbase) + (voff)[_i]), (PG8_LAS unsigned*)(lds + (bufoff) + ldsw + _i * 8192), 16, 0, 0); } while (0)
#define PG8_LDA(dst, b, h) do { _Pragma("unroll") for (int m = 0; m < 4; ++m) _Pragma("unroll") for (int k = 0; k < 2; ++k) dst[m][k] = *(const PG8_LAS bf16x8*)(lds + PG8_SA(b, h) + aoff + m * 2048 + k * 1024); } while (0)
#define PG8_LDB(dst, b, h) do { _Pragma("unroll") for (int n = 0; n < 2; ++n) _Pragma("unroll") for (int k = 0; k < 2; ++k) dst[n][k] = *(const PG8_LAS bf16x8*)(lds + PG8_SB(b, h) + boff + n * 2048 + k * 1024); } while (0)
#define PG8_MMA(ai, bj, At, Bt) do { __builtin_amdgcn_s_setprio(1); _Pragma("unroll") for (int m = 0; m < 4; ++m) _Pragma("unroll") for (int n = 0; n < 2; ++n) _Pragma("unroll") for (int k = 0; k < 2; ++k) \
        acc[ai][bj][m][n] = __builtin_amdgcn_mfma_f32_16x16x32_bf16(Bt[n][k], At[m][k], acc[ai][bj][m][n], 0, 0, 0); __builtin_amdgcn_s_setprio(0); } while (0)
#define PG8_WAIT_V(n) asm volatile("s_waitcnt vmcnt(" #n ")" ::: "memory")
#define PG8_WAIT_L(n) asm volatile("s_waitcnt lgkmcnt(" #n ")" ::: "memory")
#define PG8_BAR __builtin_amdgcn_s_barrier()
#define PG8_SCHED __builtin_amdgcn_sched_barrier(0)
    Unit cur, nxt; int ui = 0;
    if (!S.next(0, cur)) return;
    f32x4 acc[2][2][4][2];
#pragma unroll
    for (int a = 0; a < 2; ++a)
#pragma unroll
        for (int b = 0; b < 2; ++b)
#pragma unroll
            for (int m = 0; m < 4; ++m)
#pragma unroll
                for (int n = 0; n < 2; ++n) acc[a][b][m][n] = (f32x4){0.f, 0.f, 0.f, 0.f};
    bf16x8 At[4][2], B0[2][2], B1[2][2];
    const char* cA = (const char*)g.A + (size_t)cur.pm * tstep; const char* cB = (const char*)g.Bt + (size_t)cur.pn * tstep;
    S.a_ready(cur);
    if constexpr (SP2) {
        PG8_STAGE(PG8_SB(0, 0), cB, voffB); PG8_STAGE(PG8_SB(0, 1), cB + hstep, voffB); PG8_STAGE(PG8_SA(0, 0), cA, voffA); PG8_STAGE(PG8_SA(0, 1), cA + hstep, voffA);
        if (wr == 1) PG8_BAR;
        PG8_WAIT_V(2); PG8_BAR;
        PG8_STAGE(PG8_SB(1, 0), cB + kstep, voffB); PG8_STAGE(PG8_SA(1, 0), cA + kstep, voffA); PG8_STAGE(PG8_SB(1, 1), cB + hstep + kstep, voffB);
        PG8_WAIT_V(6); PG8_BAR;
    } else {
        PG8_STAGE(PG8_SB(0, 0), cB, voffB); PG8_STAGE(PG8_SA(0, 0), cA, voffA); PG8_STAGE(PG8_SB(0, 1), cB + hstep, voffB); PG8_STAGE(PG8_SA(0, 1), cA + hstep, voffA);
        if (wr == 1) PG8_BAR;
        PG8_WAIT_V(4); PG8_BAR;
        PG8_STAGE(PG8_SB(1, 0), cB + kstep, voffB); PG8_STAGE(PG8_SA(1, 0), cA + kstep, voffA); PG8_STAGE(PG8_SB(1, 1), cB + hstep + kstep, voffB);
        PG8_WAIT_V(6); PG8_BAR;
    }
    for (;;) {
        const bool has_next = S.next(ui + 1, nxt);
        const char* nA = has_next ? (const char*)g.A + (size_t)nxt.pm * tstep : cA; const char* nB = has_next ? (const char*)g.Bt + (size_t)nxt.pn * tstep : cB;
        for (int t = 0; t < nt; t += 2) {
            const bool last = (t == nt - 2);
            const char* a1 = cA + (size_t)(t + 1) * kstep;
            const char* a2 = last ? nA : cA + (size_t)(t + 2) * kstep; const char* b2 = last ? nB : cB + (size_t)(t + 2) * kstep;
            const char* a3 = a2 + kstep; const char* b3 = b2 + kstep;
            if (last && has_next) S.a_ready(nxt);
            if constexpr (SP2) {
            PG8_LDB(B0, 0, 0); PG8_LDB(B1, 0, 1); PG8_SCHED; PG8_LDA(At, 0, 0); PG8_STAGE(PG8_SA(1, 1), a1 + hstep, voffA);
            PG8_WAIT_V(8); PG8_WAIT_L(0); PG8_BAR; PG8_MMA(0, 0, At, B0); PG8_MMA(0, 1, At, B1); PG8_BAR; PG8_SCHED;
            PG8_LDA(At, 0, 1); PG8_STAGE(PG8_SB(0, 0), b2, voffB); PG8_STAGE(PG8_SB(0, 1), b2 + hstep, voffB); PG8_STAGE(PG8_SA(0, 0), a2, voffA);
            PG8_WAIT_V(8); PG8_WAIT_L(0); PG8_BAR; PG8_MMA(1, 0, At, B0); PG8_MMA(1, 1, At, B1); PG8_BAR; PG8_SCHED;
            PG8_LDB(B0, 1, 0); PG8_LDB(B1, 1, 1); PG8_SCHED; PG8_LDA(At, 1, 0); PG8_STAGE(PG8_SA(0, 1), a2 + hstep, voffA);
            PG8_WAIT_V(8); PG8_WAIT_L(0); PG8_BAR; PG8_MMA(0, 0, At, B0); PG8_MMA(0, 1, At, B1); PG8_BAR; PG8_SCHED;
            PG8_LDA(At, 1, 1); PG8_STAGE(PG8_SB(1, 0), b3, voffB); PG8_STAGE(PG8_SB(1, 1), b3 + hstep, voffB); PG8_STAGE(PG8_SA(1, 0), a3, voffA);
            PG8_WAIT_V(8); PG8_WAIT_L(0); PG8_BAR; PG8_MMA(1, 0, At, B0); PG8_MMA(1, 1, At, B1); PG8_BAR; PG8_SCHED;
            } else {
            PG8_LDB(B0, 0, 0); PG8_SCHED; PG8_LDA(At, 0, 0); PG8_STAGE(PG8_SA(1, 1), a1 + hstep, voffA);
            PG8_WAIT_L(8); PG8_BAR; PG8_WAIT_L(0); PG8_MMA(0, 0, At, B0); PG8_BAR; PG8_SCHED;
            PG8_LDB(B1, 0, 1); PG8_STAGE(PG8_SB(0, 0), b2, voffB);
            PG8_BAR; PG8_WAIT_L(0); PG8_MMA(0, 1, At, B1); PG8_BAR;
            PG8_LDA(At, 0, 1); PG8_STAGE(PG8_SA(0, 0), a2, voffA);
            PG8_BAR; PG8_WAIT_L(0); PG8_MMA(1, 0, At, B0); PG8_BAR; PG8_SCHED;
            PG8_STAGE(PG8_SB(0, 1), b2 + hstep, voffB);
            PG8_WAIT_V(6); PG8_BAR; PG8_MMA(1, 1, At, B1); PG8_BAR;
            PG8_LDB(B0, 1, 0); PG8_SCHED; PG8_LDA(At, 1, 0); PG8_STAGE(PG8_SA(0, 1), a2 + hstep, voffA);
            PG8_WAIT_L(8); PG8_BAR; PG8_WAIT_L(0); PG8_MMA(0, 0, At, B0); PG8_BAR; PG8_SCHED;
            PG8_LDB(B1, 1, 1); PG8_STAGE(PG8_SB(1, 0), b3, voffB);
            PG8_BAR; PG8_WAIT_L(0); PG8_MMA(0, 1, At, B1); PG8_BAR;
            PG8_LDA(At, 1, 1); PG8_STAGE(PG8_SA(1, 0), a3, voffA);
            PG8_BAR; PG8_WAIT_L(0); PG8_MMA(1, 0, At, B0); PG8_BAR; PG8_SCHED;
            PG8_STAGE(PG8_SB(1, 1), b3 + hstep, voffB);
            PG8_WAIT_V(6); PG8_BAR; PG8_MMA(1, 1, At, B1); PG8_BAR;
            }
        }
        if constexpr (ALIGN_EPI) { if (wr == 0) PG8_BAR; }
        if constexpr (!Epi::AFTER_DRAIN) { E(acc, cur, wr, wc, fr, fq); S.done(cur); }
        if (!has_next) break;
#pragma unroll
        for (int a = 0; a < 2; ++a)
#pragma unroll
            for (int b = 0; b < 2; ++b)
#pragma unroll
                for (int m = 0; m < 4; ++m)
#pragma unroll
                    for (int n = 0; n < 2; ++n) acc[a][b][m][n] = (f32x4){0.f, 0.f, 0.f, 0.f};
        cur = nxt; cA = nA; cB = nB; ++ui;
        if constexpr (ALIGN_EPI) { if (wr == 1) PG8_BAR; }
    }
    PG8_WAIT_V(0);
    if constexpr (!ALIGN_EPI) { if (wr == 0) PG8_BAR; }
    PG8_BAR;
    if constexpr (Epi::AFTER_DRAIN) { E.fused(acc, cur, wr, wc, fr, fq, lds, wid, lane); S.done(cur); }
#undef PG8_SA
#undef PG8_SB
#undef PG8_STAGE
#undef PG8_LDA
#undef PG8_LDB
#undef PG8_MMA
#undef PG8_WAIT_V
#undef PG8_WAIT_L
#undef PG8_BAR
#undef PG8_SCHED
}
}

#define DI __device__ __forceinline__
#define LAS __attribute__((address_space(3)))
typedef unsigned short bf16;
typedef pg8::f32x4 f32x4;
typedef pg8::bf16x8 bf16x8;
typedef pg8::u32x4 u32x4;
typedef float f32x16 __attribute__((ext_vector_type(16)));
typedef float f32x2_t __attribute__((ext_vector_type(2)));
typedef __bf16 bf16x2_t __attribute__((ext_vector_type(2)));
typedef unsigned u32x2 __attribute__((ext_vector_type(2)));
#define MFMA32(a, b, c) __builtin_amdgcn_mfma_f32_32x32x16_bf16((a), (b), (c), 0, 0, 0)

#ifndef MK_PER_PHASE
#define MK_PER_PHASE 0
#endif

constexpr int MP = 16384, MS = 256, M = MP + MS, D = 1024, FF = 2688, NGLA = 3072, NCH = 288, SEQ = 2048;
constexpr float EPS = 1e-6f;
constexpr int NPHASE = 16;
constexpr size_t MiB = 1u << 20;
constexpr size_t WS_SSQ = 0;
constexpr size_t WS_ELAST = 1 * MiB;
constexpr size_t W_FI = 2 * MiB;
constexpr size_t W_FO = W_FI + 42 * MiB;
constexpr size_t W_GI = W_FO + 21 * MiB;
constexpr size_t W_GO = W_GI + 6 * MiB;
constexpr size_t W_KV = W_GO + 2 * MiB;
constexpr size_t W_Q = W_KV + 1 * MiB;
constexpr size_t W_AO = W_Q + 1536 * 1024;
constexpr size_t W_GLR = W_AO + 1536 * 1024;
constexpr size_t W_ROPE = W_GLR + 65536;
constexpr size_t WS_XB = 78 * MiB;
constexpr size_t WS_U1 = 111 * MiB;
constexpr size_t WS_U2 = 209 * MiB;
constexpr size_t WS_U3 = 299 * MiB;
constexpr size_t WS_LSE = 332 * MiB;
constexpr size_t WS_END = 333 * MiB;
static_assert(W_ROPE + 2056 * 32 * 8 <= WS_XB, "ws map");
constexpr size_t O_Y = 0, O_SP = (size_t)M * D, O_SS = O_SP + 1048576, O_KP = O_SS + 4194304, O_VP = O_KP + 4194304, O_KS = O_VP + 4194304, O_VS = O_KS + 65536;

constexpr int LDS_BYTES = 147456;

struct Args { const float* in[19]; float* out; unsigned char* ws; int ph_lo, ph_hi; };

DI float bf2f(bf16 b) { return __uint_as_float((unsigned)b << 16); }
DI unsigned cvtpk(float lo, float hi) { f32x2_t v = {lo, hi}; bf16x2_t b = __builtin_convertvector(v, bf16x2_t); return __builtin_bit_cast(unsigned, b); }
DI bf16 f2bf(float f) { return (bf16)(cvtpk(f, 0.f) & 0xffffu); }
DI float wave_sum(float v) {
#pragma unroll
    for (int o = 1; o < 64; o <<= 1) v += __shfl_xor(v, o);
    return v;
}
DI float wave_max(float v) {
#pragma unroll
    for (int o = 1; o < 64; o <<= 1) v = fmaxf(v, __shfl_xor(v, o));
    return v;
}
DI int swz(int x) { return (x & ~12) | ((x & 4) << 1) | ((x & 8) >> 1); }
DI int crow(int reg, int h) { return (reg & 3) + 8 * (reg >> 2) + 4 * h; }
template <int S> DI bf16x8 pack8(const f32x16& x) {
    u32x4 p; p.x = cvtpk(x[8 * S], x[8 * S + 1]); p.y = cvtpk(x[8 * S + 2], x[8 * S + 3]); p.z = cvtpk(x[8 * S + 4], x[8 * S + 5]); p.w = cvtpk(x[8 * S + 6], x[8 * S + 7]);
    return __builtin_bit_cast(bf16x8, p);
}
DI float silu(float x) { return x / (1.f + __expf(-x)); }

struct EpiSwiGLU {
    static constexpr bool PERM = false, AFTER_DRAIN = false;
    bf16* O; const float* ssq;
    DI void operator()(const f32x4 (&acc)[2][2][4][2], const pg8::Unit& u, int wr, int wc, int fr, int fq) const {
#pragma unroll
        for (int ai = 0; ai < 2; ++ai)
#pragma unroll
            for (int m = 0; m < 4; ++m) {
                const int row = u.pm * 256 + ai * 128 + wr * 64 + m * 16 + fr;
                const float rstd = rsqrtf(ssq[row] * (1.f / D) + EPS);
#pragma unroll
                for (int bj = 0; bj < 2; ++bj) {
                    const f32x4 g = acc[ai][bj][m][0] * rstd, uu = acc[ai][bj][m][1] * rstd;
                    u32x2 w; w.x = cvtpk(silu(g[0]) * uu[0], silu(g[1]) * uu[1]); w.y = cvtpk(silu(g[2]) * uu[2], silu(g[3]) * uu[3]);
                    *(u32x2*)(O + (size_t)row * FF + u.pn * 128 + bj * 64 + wc * 16 + fq * 4) = w;
                }
            }
    }
};
struct EpiResid {
    static constexpr bool PERM = false, AFTER_DRAIN = false;
    float* X; bf16* XB; float* ssq_out; float scale;
    DI void operator()(const f32x4 (&acc)[2][2][4][2], const pg8::Unit& u, int wr, int wc, int fr, int fq) const {
#pragma unroll
        for (int ai = 0; ai < 2; ++ai)
#pragma unroll
            for (int m = 0; m < 4; ++m) {
                const int row = u.pm * 256 + ai * 128 + wr * 64 + m * 16 + fr;
                float ss = 0.f;
#pragma unroll
                for (int bj = 0; bj < 2; ++bj)
#pragma unroll
                    for (int n = 0; n < 2; ++n) {
                        const size_t off = (size_t)row * D + u.pn * 256 + bj * 128 + wc * 32 + n * 16 + fq * 4;
                        f32x4 v = *(const f32x4*)(X + off) + acc[ai][bj][m][n] * scale;
                        *(f32x4*)(X + off) = v;
                        ss += (v[0] * v[0] + v[1] * v[1]) + (v[2] * v[2] + v[3] * v[3]);
                        if (XB) { u32x2 w; w.x = cvtpk(v[0], v[1]); w.y = cvtpk(v[2], v[3]); *(u32x2*)(XB + off) = w; }
                    }
                if (ssq_out) { ss += __shfl_xor(ss, 16); ss += __shfl_xor(ss, 32); if (fq == 0) atomicAdd(ssq_out + row, ss); }
                asm volatile("" ::: "memory");
            }
    }
};
struct EpiScale {
    static constexpr bool PERM = false, AFTER_DRAIN = false;
    bf16* Ob; float* Of; int ldc; const float* ssq;
    DI void operator()(const f32x4 (&acc)[2][2][4][2], const pg8::Unit& u, int wr, int wc, int fr, int fq) const {
#pragma unroll
        for (int ai = 0; ai < 2; ++ai)
#pragma unroll
            for (int m = 0; m < 4; ++m) {
                const int row = u.pm * 256 + ai * 128 + wr * 64 + m * 16 + fr;
                const float rstd = rsqrtf(ssq[row] * (1.f / D) + EPS);
#pragma unroll
                for (int bj = 0; bj < 2; ++bj)
#pragma unroll
                    for (int n = 0; n < 2; ++n) {
                        const size_t off = (size_t)row * ldc + u.pn * 256 + bj * 128 + wc * 32 + n * 16 + fq * 4;
                        const f32x4 v = acc[ai][bj][m][n] * rstd;
                        if (Ob) { u32x2 w; w.x = cvtpk(v[0], v[1]); w.y = cvtpk(v[2], v[3]); *(u32x2*)(Ob + off) = w; }
                        else *(f32x4*)(Of + off) = v;
                    }
            }
    }
};

template <int MODE> DI int src_col(int n) {
    if (MODE == 1) { const int G = n >> 5, w = n & 31; return w < 16 ? G * 16 + w : FF + G * 16 + (w - 16); }
    if (MODE == 2) return n < 2048 ? n : n + 16;
    return n;
}
template <int MODE> DI void transpose_item(const float* W, int K, int ldw, int Ndst, bf16* WT, const float* gain, LAS float* scr, int item, int lane) {
    const int nblk = Ndst / 32, kb = item / nblk, nb = item % nblk, k0 = 64 * kb, n0 = 32 * nb;
    const int sc = src_col<MODE>(n0 + (lane & 31));
#pragma unroll 8
    for (int i = 0; i < 32; ++i) { const int kk = 2 * i + (lane >> 5); const float g = gain ? gain[k0 + kk] : 1.f; scr[kk * 33 + (lane & 31)] = W[(size_t)(k0 + kk) * ldw + sc] * g; }
    asm volatile("s_waitcnt lgkmcnt(0)" ::: "memory");
    const int c = lane & 7;
#pragma unroll
    for (int j = 0; j < 4; ++j) { const int n = (lane >> 3) + 8 * j; const LAS float* s = scr + (8 * c) * 33 + n;
        u32x4 o; o.x = cvtpk(s[0 * 33], s[1 * 33]); o.y = cvtpk(s[2 * 33], s[3 * 33]); o.z = cvtpk(s[4 * 33], s[5 * 33]); o.w = cvtpk(s[6 * 33], s[7 * 33]);
        *(u32x4*)(WT + (size_t)(n0 + n) * K + k0 + 8 * c) = o; }
    asm volatile("s_waitcnt lgkmcnt(0)" ::: "memory");
}

DI void p0_prologue(const Args& a, LAS unsigned char* lds, int tid, int lane, int wave) {
    unsigned char* ws = a.ws;
    LAS float* scr = (LAS float*)(lds + wave * 16384);
    const int G = gridDim.x, gw = blockIdx.x * 8 + wave, NGW = G * 8;
    const float* gains = a.in[5];
    constexpr int I_FI = 16 * 168, I_FO = 42 * 32, I_GI = 16 * 96, I_GO = 16 * 32, I_KV = 16 * 16, I_Q = 16 * 24, I_AO = 12 * 32;
    constexpr int NITEMS = 4 * I_FI + 4 * I_FO + I_GI + I_GO + I_KV + I_Q + I_AO;
    for (int it = gw; it < NITEMS; it += NGW) {
        int r = it;
        if (r < 4 * I_FI) { const int mi = r / I_FI, l = mi >> 1, i = mi & 1; transpose_item<1>(a.in[6] + (size_t)mi * D * 2 * FF, D, 2 * FF, 2 * FF, (bf16*)(ws + W_FI) + (size_t)mi * 2 * FF * D, gains + (l * 3 + (i ? 2 : 0)) * D, scr, r % I_FI, lane); continue; } r -= 4 * I_FI;
        if (r < 4 * I_FO) { const int mi = r / I_FO; transpose_item<0>(a.in[7] + (size_t)mi * FF * D, FF, D, D, (bf16*)(ws + W_FO) + (size_t)mi * D * FF, nullptr, scr, r % I_FO, lane); continue; } r -= 4 * I_FO;
        if (r < I_GI) { transpose_item<2>(a.in[8], D, 3088, NGLA, (bf16*)(ws + W_GI), gains + 1 * D, scr, r, lane); continue; } r -= I_GI;
        if (r < I_GO) { transpose_item<0>(a.in[12], D, D, D, (bf16*)(ws + W_GO), nullptr, scr, r, lane); continue; } r -= I_GO;
        if (r < I_KV) { transpose_item<0>(a.in[14], D, 512, 512, (bf16*)(ws + W_KV), a.in[13], scr, r, lane); continue; } r -= I_KV;
        if (r < I_Q) { transpose_item<0>(a.in[16], D, 768, 768, (bf16*)(ws + W_Q), gains + 4 * D, scr, r, lane); continue; } r -= I_Q;
        transpose_item<0>(a.in[18], 768, D, D, (bf16*)(ws + W_AO), nullptr, scr, r, lane);
    }
    float* ssq = (float*)(ws + WS_SSQ);
    for (int m = gw; m < M; m += NGW) {
        const float* xr = m < MP ? a.in[0] + (size_t)m * D : a.in[1] + (size_t)(m - MP) * D;
        float s = 0.f;
#pragma unroll
        for (int j = 0; j < 4; ++j) {
            const f32x4 v = *((const f32x4*)xr + lane + 64 * j);
            *((f32x4*)(a.out + (size_t)m * D) + lane + 64 * j) = v;
            u32x2 w; w.x = cvtpk(v[0], v[1]); w.y = cvtpk(v[2], v[3]);
            *((u32x2*)((bf16*)(ws + WS_XB) + (size_t)m * D) + lane + 64 * j) = w;
            s += (v[0] * v[0] + v[1] * v[1]) + (v[2] * v[2] + v[3] * v[3]);
        }
        s = wave_sum(s);
        if (lane == 0) ssq[m] = s;
    }
    const int gt = blockIdx.x * 512 + tid, NGT = G * 512;
    for (int i = gt; i < 5 * M; i += NGT) ssq[M + i] = 0.f;
    for (int i = gt; i < 2056 * 32; i += NGT) {
        const int p = i >> 5, f = i & 31; const int pos = p < 2048 ? p : 8192 + (p - 2048);
        const double inv = pow(10000.0, -(double)f / 32.0); double sn, cs; sincos((double)pos * inv, &sn, &cs);
        ((float*)(ws + W_ROPE))[2 * i] = (float)cs; ((float*)(ws + W_ROPE))[2 * i + 1] = (float)sn;
    }
    for (int i = gt; i < D * 16; i += NGT) { const int k = i >> 4, c = i & 15; ((float*)(ws + W_GLR))[i] = a.in[8][(size_t)k * 3088 + 2048 + c] * gains[1 * D + k]; }
}

DI float logsig16(float z) { return -(fmaxf(-z, 0.f) + log1pf(__expf(-fabsf(z)))) * (1.f / 16.f); }
DI void gla_prep(const Args& a, LAS unsigned char* lds, int tid) {
    unsigned char* ws = a.ws;
    LAS float* glr = (LAS float*)lds;
    const bf16* qkvr = (const bf16*)(ws + WS_U1);
    bf16* QH = (bf16*)(ws + WS_U2); bf16* KH = QH + (size_t)NCH * 4 * 64 * 128; bf16* KDT = KH + (size_t)NCH * 4 * 64 * 128; bf16* VT = KDT + (size_t)NCH * 4 * 64 * 128;
    float* elast = (float*)(ws + WS_ELAST);
    const float* ssq1 = (const float*)(ws + WS_SSQ) + 1 * M;
    const float* Wglr = (const float*)(ws + W_GLR);
    for (int ch = blockIdx.x; ch < NCH; ch += gridDim.x) {
        const bool smp = ch >= 256; const int T = smp ? 8 : 64; const int row0 = smp ? MP + 8 * (ch - 256) : 64 * ch;
        {
            const int t = tid >> 3, part = tid & 7; float acc[16];
#pragma unroll
            for (int i = 0; i < 16; ++i) acc[i] = 0.f;
            if (t < T) {
                const float* xr = a.out + (size_t)(row0 + t) * D + part * 128; const float* wr = Wglr + part * 128 * 16;
                for (int k = 0; k < 128; k += 4) {
                    const f32x4 xv = *(const f32x4*)(xr + k);
#pragma unroll
                    for (int kk = 0; kk < 4; ++kk) {
#pragma unroll
                        for (int q = 0; q < 4; ++q) { const f32x4 w = *(const f32x4*)(wr + (k + kk) * 16 + 4 * q); acc[4 * q] += xv[kk] * w[0]; acc[4 * q + 1] += xv[kk] * w[1]; acc[4 * q + 2] += xv[kk] * w[2]; acc[4 * q + 3] += xv[kk] * w[3]; }
                    }
                }
            }
#pragma unroll
            for (int i = 0; i < 16; ++i) { acc[i] += __shfl_xor(acc[i], 1); acc[i] += __shfl_xor(acc[i], 2); acc[i] += __shfl_xor(acc[i], 4); }
            if (part == 0) { const float rstd = t < T ? rsqrtf(ssq1[row0 + t] * (1.f / D) + EPS) : 0.f;
#pragma unroll
                for (int i = 0; i < 16; ++i) glr[t * 16 + i] = acc[i] * rstd; }
        }
        __syncthreads();
        {
            const int col = tid, h = col >> 7, d = col & 127;
            float w2[16];
#pragma unroll
            for (int i = 0; i < 16; ++i) w2[i] = a.in[9][i * 512 + col];
            const float bias = a.in[10][col];
            float total = 0.f;
            for (int t = 0; t < T; ++t) { float z = bias;
#pragma unroll
                for (int i = 0; i < 16; ++i) z += glr[t * 16 + i] * w2[i];
                total += logsig16(z); }
            float cum = 0.f;
            bf16* qh = QH + ((size_t)(ch * 4 + h) * 64) * 128 + swz(d);
            bf16* kh = KH + ((size_t)(ch * 4 + h) * 64) * 128 + swz(d);
            bf16* kdt = KDT + ((size_t)(ch * 4 + h) * 128 + d) * 64;
            for (int t16 = 0; t16 < 4; ++t16) {
                unsigned kd[8];
#pragma unroll
                for (int i = 0; i < 8; ++i) kd[i] = 0u;
#pragma unroll
                for (int tt = 0; tt < 16; ++tt) {
                    const int t = 16 * t16 + tt; const bool valid = t < T;
                    float qv = 0.f, kv = 0.f;
                    if (valid) { float z = bias;
#pragma unroll
                        for (int i = 0; i < 16; ++i) z += glr[t * 16 + i] * w2[i];
                        cum += logsig16(z);
                        qv = bf2f(qkvr[(size_t)(row0 + t) * NGLA + col]); kv = bf2f(qkvr[(size_t)(row0 + t) * NGLA + 512 + col]); }
                    qh[t * 128] = f2bf(qv * 0.08838834764831845f * __expf(cum));
                    kh[t * 128] = f2bf(kv * __expf(-cum));
                    const unsigned kdv = f2bf(kv * __expf(total - cum));
                    const int p = (tt & ~12) | ((tt & 4) << 1) | ((tt & 8) >> 1);
                    kd[p >> 1] |= kdv << (16 * (p & 1));
                }
                u32x4 o0, o1; o0.x = kd[0]; o0.y = kd[1]; o0.z = kd[2]; o0.w = kd[3]; o1.x = kd[4]; o1.y = kd[5]; o1.z = kd[6]; o1.w = kd[7];
                *(u32x4*)(kdt + 16 * t16) = o0; *(u32x4*)(kdt + 16 * t16 + 8) = o1;
            }
            elast[ch * 512 + col] = __expf(total);
        }
#pragma unroll 1
        for (int rep = 0; rep < 2; ++rep) {
            const int vc = tid + 512 * rep, h = vc >> 8, vv = vc & 255;
            bf16* vt = VT + ((size_t)(ch * 4 + h) * 256 + vv) * 64;
            for (int t16 = 0; t16 < 4; ++t16) {
                unsigned kd[8];
#pragma unroll
                for (int i = 0; i < 8; ++i) kd[i] = 0u;
#pragma unroll
                for (int tt = 0; tt < 16; ++tt) {
                    const int t = 16 * t16 + tt;
                    const unsigned v = t < T ? (unsigned)qkvr[(size_t)(row0 + t) * NGLA + 1024 + vc] : 0u;
                    const int p = (tt & ~12) | ((tt & 4) << 1) | ((tt & 8) >> 1);
                    kd[p >> 1] |= v << (16 * (p & 1));
                }
                u32x4 o0, o1; o0.x = kd[0]; o0.y = kd[1]; o0.z = kd[2]; o0.w = kd[3]; o1.x = kd[4]; o1.y = kd[5]; o1.z = kd[6]; o1.w = kd[7];
                *(u32x4*)(vt + 16 * t16) = o0; *(u32x4*)(vt + 16 * t16 + 8) = o1;
            }
        }
        __syncthreads();
    }
}

DI void gla_rec(const Args& a, LAS unsigned char* lds, int lane, int wave) {
    unsigned char* ws = a.ws;
    LAS float* ssqbuf = (LAS float*)lds;
    const bf16* qkvr = (const bf16*)(ws + WS_U1);
    const bf16* QH = (const bf16*)(ws + WS_U2); const bf16* KH = QH + (size_t)NCH * 4 * 64 * 128; const bf16* KDT = KH + (size_t)NCH * 4 * 64 * 128; const bf16* VT = KDT + (size_t)NCH * 4 * 64 * 128;
    const float* elast = (const float*)(ws + WS_ELAST);
    bf16* AG = (bf16*)(ws + WS_U3);
    const float* gnorm = a.in[11];
    const int r = lane & 31, hh = lane >> 5, w = wave;
    for (int u = blockIdx.x; u < 160; u += gridDim.x) {
        const bool smp = u >= 32;
        int b, h, nchunk, chunk0, T;
        if (!smp) { b = u >> 2; h = u & 3; nchunk = 32; chunk0 = b * 32; T = 64; }
        else { const int uu = u - 32; b = uu >> 2; h = uu & 3; nchunk = 1; chunk0 = 256 + b; T = 8; }
        f32x16 S[4];
#pragma unroll
        for (int dt = 0; dt < 4; ++dt)
#pragma unroll
            for (int i = 0; i < 16; ++i) S[dt][i] = 0.f;
        if (smp) {
            const float* s0 = a.in[2] + ((size_t)(b * 4 + h) * 128 + 4 * hh) * 256 + 32 * w + r;
#pragma unroll
            for (int dt = 0; dt < 4; ++dt)
#pragma unroll
                for (int g = 0; g < 4; ++g) { const float* pp = s0 + (size_t)(32 * dt + 8 * g) * 256;
                    S[dt][4 * g] = pp[0]; S[dt][4 * g + 1] = pp[256]; S[dt][4 * g + 2] = pp[512]; S[dt][4 * g + 3] = pp[768];
                    asm volatile("" ::: "memory"); }
        }
        for (int c = 0; c < nchunk; ++c) {
            const int ch = chunk0 + c; const int row0 = smp ? MP + 8 * b : b * SEQ + 64 * c;
            const bf16* qh = QH + ((size_t)(ch * 4 + h) * 64) * 128;
            const bf16* kh = KH + ((size_t)(ch * 4 + h) * 64) * 128;
            const bf16* kdt = KDT + ((size_t)(ch * 4 + h) * 128) * 64;
            const bf16* vt = VT + ((size_t)(ch * 4 + h) * 256 + 32 * w) * 64;
            f32x16 O[2];
#pragma unroll
            for (int i = 0; i < 16; ++i) { O[0][i] = 0.f; O[1][i] = 0.f; }
            bf16x8 pb00[2], pb01[2], pb11[2];
            {
                f32x16 A0;
#pragma unroll
                for (int i = 0; i < 16; ++i) A0[i] = 0.f;
#pragma unroll
                for (int s = 0; s < 8; ++s) {
                    const bf16x8 q = *(const bf16x8*)(qh + r * 128 + 16 * s + 8 * hh);
                    const bf16x8 k = *(const bf16x8*)(kh + r * 128 + 16 * s + 8 * hh);
                    O[0] = MFMA32((s & 1) ? pack8<1>(S[s >> 1]) : pack8<0>(S[s >> 1]), q, O[0]);
                    A0 = MFMA32(k, q, A0);
                }
#pragma unroll
                for (int i = 0; i < 16; ++i) if (crow(i, hh) > r) A0[i] = 0.f;
                pb00[0] = pack8<0>(A0); pb00[1] = pack8<1>(A0);
            }
            asm volatile("" ::: "memory");
            {
                f32x16 A0, A1;
#pragma unroll
                for (int i = 0; i < 16; ++i) { A0[i] = 0.f; A1[i] = 0.f; }
#pragma unroll
                for (int s = 0; s < 8; ++s) {
                    const bf16x8 q = *(const bf16x8*)(qh + (32 + r) * 128 + 16 * s + 8 * hh);
                    const bf16x8 k0 = *(const bf16x8*)(kh + r * 128 + 16 * s + 8 * hh);
                    const bf16x8 k1 = *(const bf16x8*)(kh + (32 + r) * 128 + 16 * s + 8 * hh);
                    O[1] = MFMA32((s & 1) ? pack8<1>(S[s >> 1]) : pack8<0>(S[s >> 1]), q, O[1]);
                    A0 = MFMA32(k0, q, A0);
                    A1 = MFMA32(k1, q, A1);
                }
#pragma unroll
                for (int i = 0; i < 16; ++i) if (crow(i, hh) > r) A1[i] = 0.f;
                pb01[0] = pack8<0>(A0); pb01[1] = pack8<1>(A0); pb11[0] = pack8<0>(A1); pb11[1] = pack8<1>(A1);
            }
            asm volatile("" ::: "memory");
            bf16x8 vf[4];
#pragma unroll
            for (int js = 0; js < 4; ++js) vf[js] = *(const bf16x8*)(vt + r * 64 + 16 * js + 8 * hh);
            O[0] = MFMA32(vf[0], pb00[0], O[0]); O[0] = MFMA32(vf[1], pb00[1], O[0]);
            O[1] = MFMA32(vf[0], pb01[0], O[1]); O[1] = MFMA32(vf[1], pb01[1], O[1]);
            O[1] = MFMA32(vf[2], pb11[0], O[1]); O[1] = MFMA32(vf[3], pb11[1], O[1]);
            LAS float* sb = ssqbuf + (c & 1) * 512;
#pragma unroll
            for (int it = 0; it < 2; ++it) { float ss = 0.f;
#pragma unroll
                for (int i = 0; i < 16; ++i) ss += O[it][i] * O[it][i];
                ss += __shfl_xor(ss, 32);
                if (hh == 0) sb[w * 64 + 32 * it + r] = ss; }
            __syncthreads();
#pragma unroll
            for (int it = 0; it < 2; ++it) {
                float tot = 0.f;
#pragma unroll
                for (int ww = 0; ww < 8; ++ww) tot += sb[ww * 64 + 32 * it + r];
                const float rstd = rsqrtf(tot * (1.f / 256.f) + EPS);
                const int tok = 32 * it + r;
                if (tok < T) {
                    const size_t row = (size_t)row0 + tok;
#pragma unroll
                    for (int g = 0; g < 4; ++g) {
                        const int vb = 32 * w + 8 * g + 4 * hh;
                        const u32x2 rr = *(const u32x2*)(qkvr + row * NGLA + 2048 + h * 256 + vb);
                        const f32x4 gn = *(const f32x4*)(gnorm + vb);
                        const float r0 = __uint_as_float(rr.x << 16), r1 = __uint_as_float(rr.x & 0xffff0000u), r2 = __uint_as_float(rr.y << 16), r3 = __uint_as_float(rr.y & 0xffff0000u);
                        u32x2 o; o.x = cvtpk(O[it][4 * g] * rstd * gn[0] * silu(r0), O[it][4 * g + 1] * rstd * gn[1] * silu(r1));
                        o.y = cvtpk(O[it][4 * g + 2] * rstd * gn[2] * silu(r2), O[it][4 * g + 3] * rstd * gn[3] * silu(r3));
                        *(u32x2*)(AG + row * D + h * 256 + vb) = o;
                    }
                }
            }
            asm volatile("" ::: "memory");
#pragma unroll
            for (int dt = 0; dt < 4; ++dt) {
#pragma unroll
                for (int g = 0; g < 4; ++g) { const f32x4 el = *(const f32x4*)(elast + ch * 512 + h * 128 + 32 * dt + 8 * g + 4 * hh);
                    S[dt][4 * g] *= el[0]; S[dt][4 * g + 1] *= el[1]; S[dt][4 * g + 2] *= el[2]; S[dt][4 * g + 3] *= el[3]; }
#pragma unroll
                for (int js = 0; js < 4; ++js) { const bf16x8 kd = *(const bf16x8*)(kdt + (32 * dt + r) * 64 + 16 * js + 8 * hh); S[dt] = MFMA32(kd, vf[js], S[dt]); }
            }
        }
        float* so = a.out + (smp ? O_SS : O_SP) + ((size_t)(b * 4 + h) * 128 + 4 * hh) * 256 + 32 * w + r;
#pragma unroll
        for (int dt = 0; dt < 4; ++dt)
#pragma unroll
            for (int g = 0; g < 4; ++g) { float* pp = so + (size_t)(32 * dt + 8 * g) * 256;
                pp[0] = S[dt][4 * g]; pp[256] = S[dt][4 * g + 1]; pp[512] = S[dt][4 * g + 2]; pp[768] = S[dt][4 * g + 3]; }
        __syncthreads();
    }
}

DI void kv_post_item(const Args& a, int item, int tid) {
    unsigned char* ws = a.ws;
    const float* kvraw = (const float*)(ws + WS_U2);
    bf16* Kb = (bf16*)(ws + WS_U3); bf16* VTd = Kb + (size_t)MP * 256;
    const float* rope = (const float*)(ws + W_ROPE);
    const int t = tid >> 3, sub = tid & 7, hd = sub & 3, isV = sub >> 2;
    const int row = 64 * item + t; const bool prompt = row < MP;
    const float* src = kvraw + (size_t)row * 512 + isV * 256 + hd * 64;
    float v[64];
#pragma unroll
    for (int i = 0; i < 16; ++i) { const f32x4 x = *(const f32x4*)(src + 4 * i); v[4 * i] = x[0]; v[4 * i + 1] = x[1]; v[4 * i + 2] = x[2]; v[4 * i + 3] = x[3]; }
    if (!isV) {
        float ss = 0.f;
#pragma unroll
        for (int i = 0; i < 64; ++i) ss += v[i] * v[i];
        const float rk = rsqrtf(ss * (1.f / 64.f) + EPS);
        const int pidx = prompt ? (row & 2047) : 2048 + ((row - MP) & 7);
        const float* kn = a.in[15];
#pragma unroll
        for (int i = 0; i < 32; ++i) {
            const float x1 = v[i] * rk * kn[i], x2 = v[i + 32] * rk * kn[i + 32];
            const float cs = rope[(pidx * 32 + i) * 2], sn = rope[(pidx * 32 + i) * 2 + 1];
            v[i] = x1 * cs - x2 * sn; v[i + 32] = x1 * sn + x2 * cs;
        }
        float* ok = prompt ? a.out + O_KP + (size_t)row * 256 + hd * 64 : a.out + O_KS + (size_t)(row - MP) * 256 + hd * 64;
#pragma unroll
        for (int i = 0; i < 16; ++i) { f32x4 x; x[0] = v[4 * i]; x[1] = v[4 * i + 1]; x[2] = v[4 * i + 2]; x[3] = v[4 * i + 3]; *(f32x4*)(ok + 4 * i) = x; }
        if (prompt) {
            bf16* kb = Kb + (size_t)row * 256 + hd * 64;
#pragma unroll
            for (int i = 0; i < 8; ++i) { u32x4 o; o.x = cvtpk(v[8 * i], v[8 * i + 1]); o.y = cvtpk(v[8 * i + 2], v[8 * i + 3]); o.z = cvtpk(v[8 * i + 4], v[8 * i + 5]); o.w = cvtpk(v[8 * i + 6], v[8 * i + 7]); *(u32x4*)(kb + 8 * i) = o; }
        }
    } else {
        float* ov = prompt ? a.out + O_VP + (size_t)row * 256 + hd * 64 : a.out + O_VS + (size_t)(row - MP) * 256 + hd * 64;
#pragma unroll
        for (int i = 0; i < 16; ++i) { f32x4 x; x[0] = v[4 * i]; x[1] = v[4 * i + 1]; x[2] = v[4 * i + 2]; x[3] = v[4 * i + 3]; *(f32x4*)(ov + 4 * i) = x; }
        if (prompt) {
            const int b = row >> 11, tk = row & 2047;
#pragma unroll
            for (int gi = 0; gi < 3; ++gi) {
                const int dl = gi == 0 ? 1 : (gi == 1 ? 4 : 16), L = SEQ / dl;
                const int pos = (tk % dl) * L + swz(tk / dl);
                bf16* vt = VTd + (size_t)gi * 8 * 4 * 64 * SEQ + ((size_t)(b * 4 + hd) * 64) * SEQ + pos;
#pragma unroll
                for (int i = 0; i < 64; ++i) vt[(size_t)i * SEQ] = f2bf(v[i]);
            }
        }
    }
}

DI void attn_tile(const Args& a, int b, int j, int g, int res, int a0, int lane) {
    unsigned char* ws = a.ws;
    const bf16* qraw = (const bf16*)(ws + WS_U1);
    const bf16* Kb = (const bf16*)(ws + WS_U3); const bf16* VTd = Kb + (size_t)MP * 256;
    float* OG = (float*)(ws + WS_U2); float* LSE = (float*)(ws + WS_LSE);
    const float* rope = (const float*)(ws + W_ROPE);
    const float* qn = a.in[17];
    const int r = lane & 31, hh = lane >> 5;
    const int dl = g == 0 ? 1 : (g == 1 ? 4 : 16), L = SEQ / dl;
    const int tq = dl * (a0 + r) + res; const size_t row = (size_t)b * SEQ + tq;
    const int qh = g * 4 + j;
    bf16x8 qf[4];
    {
        float x[4][8];
#pragma unroll
        for (int s = 0; s < 4; ++s) { const u32x4 v = *(const u32x4*)(qraw + row * 768 + qh * 64 + 16 * s + 8 * hh);
            x[s][0] = __uint_as_float(v.x << 16); x[s][1] = __uint_as_float(v.x & 0xffff0000u); x[s][2] = __uint_as_float(v.y << 16); x[s][3] = __uint_as_float(v.y & 0xffff0000u);
            x[s][4] = __uint_as_float(v.z << 16); x[s][5] = __uint_as_float(v.z & 0xffff0000u); x[s][6] = __uint_as_float(v.w << 16); x[s][7] = __uint_as_float(v.w & 0xffff0000u); }
        float ss = 0.f;
#pragma unroll
        for (int s = 0; s < 4; ++s)
#pragma unroll
            for (int e = 0; e < 8; ++e) ss += x[s][e] * x[s][e];
        ss += __shfl_xor(ss, 32);
        const float rq = rsqrtf(ss * (1.f / 64.f) + EPS) ;
#pragma unroll
        for (int s = 0; s < 2; ++s)
#pragma unroll
            for (int e = 0; e < 8; ++e) {
                const int i = 16 * s + 8 * hh + e;
                const float x1 = x[s][e] * rq * qn[i], x2 = x[s + 2][e] * rq * qn[i + 32];
                const float cs = rope[(tq * 32 + i) * 2], sn = rope[(tq * 32 + i) * 2 + 1];
                x[s][e] = (x1 * cs - x2 * sn) * 0.125f; x[s + 2][e] = (x1 * sn + x2 * cs) * 0.125f;
            }
#pragma unroll
        for (int s = 0; s < 4; ++s) { u32x4 p; p.x = cvtpk(x[s][0], x[s][1]); p.y = cvtpk(x[s][2], x[s][3]); p.z = cvtpk(x[s][4], x[s][5]); p.w = cvtpk(x[s][6], x[s][7]); qf[s] = __builtin_bit_cast(bf16x8, p); }
    }
    f32x16 ST[5];
#pragma unroll
    for (int kt = 0; kt < 5; ++kt) {
        int ks = a0 - 128 + 32 * kt + r; ks = ks < 0 ? 0 : ks;
        const bf16* kp = Kb + ((size_t)b * SEQ + dl * ks + res) * 256 + j * 64 + 8 * hh;
#pragma unroll
        for (int i = 0; i < 16; ++i) ST[kt][i] = 0.f;
#pragma unroll
        for (int s = 0; s < 4; ++s) { const bf16x8 kf = *(const bf16x8*)(kp + 16 * s); ST[kt] = MFMA32(kf, qf[s], ST[kt]); }
        asm volatile("" ::: "memory");
    }
    float mx = -INFINITY;
#pragma unroll
    for (int kt = 0; kt < 5; ++kt)
#pragma unroll
        for (int i = 0; i < 16; ++i) {
            const int krel = 32 * kt - 128 + crow(i, hh);
            const bool valid = (krel <= r) && (krel + 128 >= r) && (a0 + krel >= 0);
            ST[kt][i] = valid ? ST[kt][i] : -INFINITY;
            mx = fmaxf(mx, ST[kt][i]);
        }
    mx = fmaxf(mx, __shfl_xor(mx, 32));
    float den = 0.f;
#pragma unroll
    for (int kt = 0; kt < 5; ++kt)
#pragma unroll
        for (int i = 0; i < 16; ++i) { const float p = __expf(ST[kt][i] - mx); ST[kt][i] = p; den += p; }
    den += __shfl_xor(den, 32);
    f32x16 OT[2];
#pragma unroll
    for (int i = 0; i < 16; ++i) { OT[0][i] = 0.f; OT[1][i] = 0.f; }
    const bf16* vbase = VTd + (size_t)g * 8 * 4 * 64 * SEQ + ((size_t)(b * 4 + j) * 64 + r) * SEQ + res * L + 8 * hh;
#pragma unroll
    for (int kt = 0; kt < 5; ++kt) {
        const bf16x8 p0 = pack8<0>(ST[kt]), p1 = pack8<1>(ST[kt]);
        int s0 = a0 - 128 + 32 * kt; const int s0a = s0 < 0 ? 0 : s0; const int s0b = s0 + 16 < 0 ? 0 : s0 + 16;
        OT[0] = MFMA32(*(const bf16x8*)(vbase + s0a), p0, OT[0]);
        OT[1] = MFMA32(*(const bf16x8*)(vbase + (size_t)32 * SEQ + s0a), p0, OT[1]);
        OT[0] = MFMA32(*(const bf16x8*)(vbase + s0b), p1, OT[0]);
        OT[1] = MFMA32(*(const bf16x8*)(vbase + (size_t)32 * SEQ + s0b), p1, OT[1]);
        asm volatile("" ::: "memory");
    }
    const float inv = 1.f / den;
#pragma unroll
    for (int mt = 0; mt < 2; ++mt)
#pragma unroll
        for (int q = 0; q < 4; ++q) { f32x4 o; o[0] = OT[mt][4 * q] * inv; o[1] = OT[mt][4 * q + 1] * inv; o[2] = OT[mt][4 * q + 2] * inv; o[3] = OT[mt][4 * q + 3] * inv;
            *(f32x4*)(OG + row * 768 + qh * 64 + 32 * mt + 8 * q + 4 * hh) = o; }
    if (hh == 0) LSE[row * 12 + qh] = mx + __logf(den);
}

DI void attn_sample_unit(const Args& a, LAS unsigned char* lds, int unit, int lane, int wave) {
    unsigned char* ws = a.ws;
    const bf16* qraw = (const bf16*)(ws + WS_U1);
    bf16* AA = (bf16*)(ws + WS_U1 + 32 * MiB);
    const float* rope = (const float*)(ws + W_ROPE);
    const float* qn = a.in[17];
    LAS float* qs = (LAS float*)(lds + 8192 + wave * 1024);
    LAS float* ps = qs + 64;
    const int b = unit >> 5, j = (unit >> 3) & 3, t = unit & 7;
    const size_t row = (size_t)MP + 8 * b + t;
    const float* cK = a.in[3]; const float* cV = a.in[4];
    const float* nK = a.out + O_KS; const float* nV = a.out + O_VS;
    float og0 = 0.f, og1 = 0.f, og2 = 0.f, l0 = 0.f, l1 = 0.f, l2 = 0.f;
#pragma unroll 1
    for (int g = 0; g < 3; ++g) {
        const int dl = g == 0 ? 1 : (g == 1 ? 4 : 16);
        const int qh = g * 4 + j;
        const float x = bf2f(qraw[row * 768 + qh * 64 + lane]);
        const float ss = wave_sum(x * x);
        const float xn = x * rsqrtf(ss * (1.f / 64.f) + EPS) * qn[lane];
        const float xp = __shfl_xor(xn, 32);
        const int i = lane & 31;
        const float cs = rope[((2048 + t) * 32 + i) * 2], sn = rope[((2048 + t) * 32 + i) * 2 + 1];
        const float y = lane < 32 ? xn * cs - xp * sn : xp * sn + xn * cs;
        qs[lane] = y * 0.125f;
        asm volatile("s_waitcnt lgkmcnt(0)" ::: "memory");
        float mx = -INFINITY;
#pragma unroll 1
        for (int rr = 0; rr < 3; ++rr) {
            const int jj = 64 * rr + lane;
            float dot = -INFINITY;
            if (jj <= 128) {
                const int srow = 2048 + t - dl * jj;
                const float* kp = srow >= 2048 ? nK + ((size_t)(8 * b + srow - 2048) * 4 + j) * 64 : cK + (((size_t)b * 2048 + srow) * 4 + j) * 64;
                float acc = 0.f;
#pragma unroll
                for (int q = 0; q < 16; ++q) { const f32x4 kv = *(const f32x4*)(kp + 4 * q); const f32x4 qv = *(const LAS f32x4*)(qs + 4 * q); acc += kv[0] * qv[0] + kv[1] * qv[1] + kv[2] * qv[2] + kv[3] * qv[3]; }
                dot = acc;
            }
            ps[jj] = dot; mx = fmaxf(mx, dot);
            asm volatile("" ::: "memory");
        }
        mx = wave_max(mx);
        float ds = 0.f;
#pragma unroll 1
        for (int rr = 0; rr < 3; ++rr) { const int jj = 64 * rr + lane; const float pv = __expf(ps[jj] - mx); ps[jj] = pv; ds += pv; }
        const float den = wave_sum(ds);
        asm volatile("s_waitcnt lgkmcnt(0)" ::: "memory");
        float o = 0.f;
#pragma unroll 4
        for (int jj = 0; jj <= 128; ++jj) {
            const float pj = ps[jj];
            const int srow = 2048 + t - dl * jj;
            const float* vp = srow >= 2048 ? nV + ((size_t)(8 * b + srow - 2048) * 4 + j) * 64 : cV + (((size_t)b * 2048 + srow) * 4 + j) * 64;
            o += pj * vp[lane];
        }
        { const float ov = o / den, lv = mx + __logf(den); if (g == 0) { og0 = ov; l0 = lv; } else if (g == 1) { og1 = ov; l1 = lv; } else { og2 = ov; l2 = lv; } }
        asm volatile("s_waitcnt lgkmcnt(0)" ::: "memory");
    }
    const float lm = fmaxf(fmaxf(l0, l1), l2);
    const float e0 = __expf(l0 - lm), e1 = __expf(l1 - lm), e2 = __expf(l2 - lm), is = 1.f / (e0 + e1 + e2);
    AA[row * 768 + (0 + j) * 64 + lane] = f2bf(og0 * e0 * is);
    AA[row * 768 + (4 + j) * 64 + lane] = f2bf(og1 * e1 * is);
    AA[row * 768 + (8 + j) * 64 + lane] = f2bf(og2 * e2 * is);
}

DI void attn_phase(const Args& a, LAS unsigned char* lds, int tid, int lane, int wave) {
    unsigned char* ws = a.ws;
    const int G = gridDim.x, GP = G > 1 ? G / 2 : 1;
    if ((int)blockIdx.x < GP) {
        const float* OG = (const float*)(ws + WS_U2); const float* LSE = (const float*)(ws + WS_LSE);
        bf16* AA = (bf16*)(ws + WS_U1 + 32 * MiB);
        for (int u = blockIdx.x; u < 128; u += GP) {
            const int b = u >> 4, j = (u >> 2) & 3, sp = u & 3, T0 = 512 * sp;
            for (int jb = wave; jb < 48; jb += 8) {
                const int g = jb >> 4, q = jb & 15;
                const int dl = g == 0 ? 1 : (g == 1 ? 4 : 16), tpr = 16 / dl;
                const int res = q / tpr, a0 = T0 / dl + 32 * (q % tpr);
                attn_tile(a, b, j, g, res, a0, lane);
            }
            __builtin_amdgcn_fence(__ATOMIC_RELEASE, "agent");
            __syncthreads();
            __builtin_amdgcn_fence(__ATOMIC_ACQUIRE, "agent");
            {
                const size_t row = (size_t)b * SEQ + T0 + tid;
                const float l0 = LSE[row * 12 + j], l1 = LSE[row * 12 + 4 + j], l2 = LSE[row * 12 + 8 + j];
                const float lm = fmaxf(fmaxf(l0, l1), l2);
                const float e0 = __expf(l0 - lm), e1 = __expf(l1 - lm), e2 = __expf(l2 - lm), is = 1.f / (e0 + e1 + e2);
#pragma unroll
                for (int g = 0; g < 3; ++g) {
                    const float wg = (g == 0 ? e0 : (g == 1 ? e1 : e2)) * is;
                    const float* src = OG + row * 768 + (g * 4 + j) * 64; bf16* dst = AA + row * 768 + (g * 4 + j) * 64;
#pragma unroll
                    for (int i = 0; i < 8; ++i) { const f32x4 x0 = *(const f32x4*)(src + 8 * i), x1 = *(const f32x4*)(src + 8 * i + 4);
                        u32x4 o; o.x = cvtpk(x0[0] * wg, x0[1] * wg); o.y = cvtpk(x0[2] * wg, x0[3] * wg); o.z = cvtpk(x1[0] * wg, x1[1] * wg); o.w = cvtpk(x1[2] * wg, x1[3] * wg);
                        *(u32x4*)(dst + 8 * i) = o; }
                }
            }
            __syncthreads();
        }
    } else {
        const int nb = G - GP;
        for (int u = ((int)blockIdx.x - GP) * 8 + wave; u < 1024; u += nb * 8) attn_sample_unit(a, lds, u, lane, wave);
    }
}

__global__ void __launch_bounds__(512, 2) mk_fwd(Args a) {
    extern __shared__ __attribute__((aligned(16))) unsigned char lds_raw[];
    LAS unsigned char* lds = (LAS unsigned char*)lds_raw;
    cg::grid_group grid = cg::this_grid();
    const int tid = threadIdx.x, lane = tid & 63, wave = __builtin_amdgcn_readfirstlane(tid >> 6);
    unsigned char* ws = a.ws;
    const int lo = a.ph_lo, hi = a.ph_hi, G = gridDim.x, bx = blockIdx.x;
    float* ssq = (float*)(ws + WS_SSQ);
    bf16* XB = (bf16*)(ws + WS_XB);
    bf16* ACT = (bf16*)(ws + WS_U1);
#define IN(k) (lo <= (k) && (k) < hi)
#define SEAM(k) do { if (IN(k) && IN((k) + 1)) grid.sync(); } while (0)
#define GEMM(EpiT, E, Aptr, Bptr, N_, K_, cidx) do { pg8::Gemm g_{(const pg8::bf16_t*)(Aptr), (const pg8::bf16_t*)(Bptr), M, (N_), (K_)}; pg8::StaticOrder S_; S_.init(M, (N_), G, (cidx)); \
        pg8::gemm_phase<EpiT, pg8::StaticOrder, true, true>(lds, g_, S_, E); } while (0)
#define FFN_IN(mi, slot) do { EpiSwiGLU E_{ACT, ssq + (slot) * M}; GEMM(EpiSwiGLU, E_, XB, (bf16*)(ws + W_FI) + (size_t)(mi) * 2 * FF * D, 2 * FF, D, bx); } while (0)
#define FFN_OUT(mi, slot, last) do { EpiResid E_{a.out, (last) ? nullptr : XB, (last) ? nullptr : ssq + (slot) * M, 0.5f}; GEMM(EpiResid, E_, ACT, (bf16*)(ws + W_FO) + (size_t)(mi) * D * FF, D, FF, bx); } while (0)

    if (IN(0)) { p0_prologue(a, lds, tid, lane, wave); __syncthreads(); } SEAM(0);
    if (IN(1)) { FFN_IN(0, 0); } SEAM(1);
    if (IN(2)) { FFN_OUT(0, 1, false); } SEAM(2);
    if (IN(3)) { EpiScale E_{(bf16*)(ws + WS_U1), nullptr, NGLA, ssq + 1 * M}; GEMM(EpiScale, E_, XB, ws + W_GI, NGLA, D, bx); } SEAM(3);
    if (IN(4)) { gla_prep(a, lds, tid); } SEAM(4);
    if (IN(5)) { gla_rec(a, lds, lane, wave); } SEAM(5);
    if (IN(6)) { EpiResid E_{a.out, XB, ssq + 2 * M, 1.0f}; GEMM(EpiResid, E_, ws + WS_U3, ws + W_GO, D, D, bx); } SEAM(6);
    if (IN(7)) { FFN_IN(1, 2); } SEAM(7);
    if (IN(8)) { FFN_OUT(1, 3, false); } SEAM(8);
    if (IN(9)) {
        { EpiScale E_{nullptr, (float*)(ws + WS_U2), 512, ssq + 3 * M}; GEMM(EpiScale, E_, XB, ws + W_KV, 512, D, bx); }
        { EpiSwiGLU E_{ACT, ssq + 3 * M}; GEMM(EpiSwiGLU, E_, XB, (bf16*)(ws + W_FI) + (size_t)2 * 2 * FF * D, 2 * FF, D, (G == 256) ? ((bx + 120) & 255) : bx); }
    } SEAM(9);
    if (IN(10)) {
        FFN_OUT(2, 4, false);
        if (G > 8) { if (bx >= 4) for (int it = bx - 4; it < M / 64; it += G - 4) kv_post_item(a, it, tid); }
        else for (int it = bx; it < M / 64; it += G) kv_post_item(a, it, tid);
    } SEAM(10);
    if (IN(11)) { EpiScale E_{(bf16*)(ws + WS_U1), nullptr, 768, ssq + 4 * M}; GEMM(EpiScale, E_, XB, ws + W_Q, 768, D, bx); } SEAM(11);
    if (IN(12)) { attn_phase(a, lds, tid, lane, wave); } SEAM(12);
    if (IN(13)) { EpiResid E_{a.out, XB, ssq + 5 * M, 1.0f}; GEMM(EpiResid, E_, ws + WS_U1 + 32 * MiB, ws + W_AO, D, 768, bx); } SEAM(13);
    if (IN(14)) { FFN_IN(3, 5); } SEAM(14);
    if (IN(15)) { FFN_OUT(3, 0, true); }
}

extern "C" void kernel_launch(void* const* d_in, const int* in_sizes, int n_in, void* d_out, int out_size, void* d_ws, size_t ws_size, hipStream_t stream) {
    static int grid = 0;
    if (grid == 0) {
        if (n_in != 19 || ws_size < WS_END) { fprintf(stderr, "kernel_launch: expected 19 inputs and >= %zu bytes of workspace (got %d, %zu)\n", (size_t)WS_END, n_in, ws_size); grid = -1; return; }
        int dev = 0, cus = 0, per_cu = 0;
        (void)hipGetDevice(&dev); (void)hipDeviceGetAttribute(&cus, hipDeviceAttributeMultiprocessorCount, dev);
        if (hipFuncSetAttribute((const void*)mk_fwd, hipFuncAttributeMaxDynamicSharedMemorySize, LDS_BYTES) != hipSuccess) { fprintf(stderr, "kernel_launch: hipFuncSetAttribute failed\n"); grid = -1; return; }
        if (hipOccupancyMaxActiveBlocksPerMultiprocessor(&per_cu, (const void*)mk_fwd, 512, LDS_BYTES) != hipSuccess || per_cu < 1) { fprintf(stderr, "kernel_launch: occupancy query failed (%d)\n", per_cu); per_cu = 1; }
        (void)hipGetLastError();
        grid = cus * (per_cu > 1 ? 1 : per_cu);
        if (grid <= 0) grid = 256;
    }
    if (grid < 0) return;
    Args a{};
    for (int i = 0; i < 19; ++i) a.in[i] = (const float*)d_in[i];
    a.out = (float*)d_out; a.ws = (unsigned char*)d_ws;
#if MK_PER_PHASE
    for (int p = 0; p < NPHASE; ++p) { a.ph_lo = p; a.ph_hi = p + 1; hipLaunchKernelGGL(mk_fwd, dim3(grid), dim3(512), LDS_BYTES, stream, a); }
#else
    a.ph_lo = 0; a.ph_hi = NPHASE;
    void* args[] = {&a};
    hipError_t e = hipLaunchCooperativeKernel((const void*)mk_fwd, dim3(grid), dim3(512), args, LDS_BYTES, stream);
    if (e != hipSuccess) fprintf(stderr, "kernel_launch: cooperative launch failed: %s (grid %d)\n", hipGetErrorString(e), grid);
#endif
}
```

```cpp
#include <hip/hip_runtime.h>
#include <hip/hip_cooperative_groups.h>
#include <cstdio>
#include <cstdint>
namespace cg = cooperative_groups;
namespace pg8 {
#define PG8_LAS __attribute__((address_space(3)))
typedef unsigned short bf16_t;
typedef short bf16x8 __attribute__((ext_vector_type(8)));
typedef float f32x4 __attribute__((ext_vector_type(4)));
typedef unsigned u32x4 __attribute__((ext_vector_type(4)));
constexpr int BM = 256, BK = 64, HALF = 128, HTB = HALF * BK * 2  , STAGE_BYTES = 8 * HTB, NXCD = 8, WGM = 8;

__host__ __device__ __forceinline__ int lds_byte(int r, int c) { const int st = (r >> 4) * 2 + (c >> 5), rr = r & 15, cc = c & 31, ob = rr * 64 + cc * 2; return st * 1024 + (ob ^ (((ob >> 9) & 1) << 5)); }
__host__ __device__ __forceinline__ void stage_rc(int b, int& R, int& C) { const int st = b / 1024, sb = b % 1024, swz = sb ^ (((sb >> 9) & 1) << 5); R = (st >> 1) * 16 + swz / 64; C = (st & 1) * 32 + (swz % 64) / 2; }
__host__ __device__ __forceinline__ int perm32(int rho) { const int n = rho >> 4, i = rho & 15; return 8 * (i >> 2) + 4 * n + (i & 3); }

struct Unit { int pm, pn; };
struct Gemm { const bf16_t* A; const bf16_t* Bt; int M, N, K; };

struct StaticOrder {
    int nM, nN, nwg, G, c;
    __host__ __device__ void init(int M, int N, int G_, int c_) { nM = M / BM; nN = N / BM; nwg = nM * nN; G = G_; c = c_; }
    __host__ __device__ bool next(int i, Unit& u) const {
        const long L = (long)i * G + c; if (L >= nwg) return false;
        int wgid = (int)L; { const int q = nwg / NXCD, r = nwg % NXCD, xcd = wgid % NXCD, off = wgid / NXCD; wgid = (xcd < r ? xcd * (q + 1) : r * (q + 1) + (xcd - r) * q) + off; }
        const int nig = WGM * nN, gid = wgid / nig, fm = gid * WGM, gsz = (nM - fm) < WGM ? (nM - fm) : WGM;
        u.pm = fm + ((wgid % nig) % gsz); u.pn = (wgid % nig) / gsz; return true;
    }
    __device__ __forceinline__ void a_ready(const Unit&) const {}
    __device__ __forceinline__ void done(const Unit&) const {}
};

__device__ __forceinline__ unsigned cvt_pk_bf16(float lo, float hi) { unsigned r; asm volatile("v_cvt_pk_bf16_f32 %0, %1, %2" : "=v"(r) : "v"(lo), "v"(hi)); return r; }
typedef float f32x2 __attribute__((ext_vector_type(2)));
__device__ __forceinline__ f32x2 gelu_pk(f32x2 v) {
    const f32x2 av = __builtin_elementwise_abs(v), d = av * 0.2316418882f + 1.0f;
    f32x2 t; t.x = __builtin_amdgcn_rcpf(d.x); t.y = __builtin_amdgcn_rcpf(d.y);
    f32x2 q = t * 0.5307027145f + (-0.7265760135f); q = q * t + 0.7107068705f; q = q * t + (-0.142248368f); q = q * t + 0.127414796f; q = q * t;
    const f32x2 s = (v * v) * (-0.72134752044f);
    f32x2 e; e.x = __builtin_amdgcn_exp2f(s.x); e.y = __builtin_amdgcn_exp2f(s.y);
    const f32x2 m = v * (q * e), r = v - m;
    f32x2 o; o.x = v.x < 0.f ? m.x : r.x; o.y = v.y < 0.f ? m.y : r.y; return o;
}

template <int ACT  > struct EpiBf16 {
    static constexpr bool PERM = true, AFTER_DRAIN = false; static_assert(ACT == 0 || ACT == 1, "EpiBf16: ACT is 0 (none) or 1 (gelu_pk)");
    bf16_t* O; int ldc; const float* bias; int split_cols; size_t split_stride; float scale0;
    __device__ __forceinline__ void operator()(const f32x4 (&acc)[2][2][4][2], const Unit& u, int wr, int wc, int fr, int fq) const {
        const int row0 = u.pm * BM + wr * 64 + fr; int colt = u.pn * BM; bf16_t* base = O;
        float sc = 1.f; if (split_cols) { const int t = colt / split_cols; base += (size_t)t * split_stride; colt -= t * split_cols; if (t == 0) sc = scale0; }
        const int col0 = colt + wc * 32 + 8 * fq, bcol0 = u.pn * BM + wc * 32 + 8 * fq;
        f32x4 bv[2][2];
#pragma unroll
        for (int bj = 0; bj < 2; ++bj)
#pragma unroll
            for (int n = 0; n < 2; ++n) bv[bj][n] = bias ? *(const f32x4*)(bias + bcol0 + bj * HALF + 4 * n) : (f32x4){0.f, 0.f, 0.f, 0.f};
#pragma unroll
        for (int ai = 0; ai < 2; ++ai)
#pragma unroll
            for (int m = 0; m < 4; ++m) { bf16_t* rowp = base + (size_t)(row0 + ai * HALF + m * 16) * ldc + col0;
#pragma unroll
                for (int bj = 0; bj < 2; ++bj) { f32x4 v0 = acc[ai][bj][m][0] + bv[bj][0], v1 = acc[ai][bj][m][1] + bv[bj][1];
                    if (ACT == 1) { f32x2 a = gelu_pk((f32x2){v0[0], v0[1]}), b = gelu_pk((f32x2){v0[2], v0[3]}), c = gelu_pk((f32x2){v1[0], v1[1]}), d = gelu_pk((f32x2){v1[2], v1[3]});
                        v0 = (f32x4){a.x, a.y, b.x, b.y}; v1 = (f32x4){c.x, c.y, d.x, d.y}; }
                    v0 = v0 * sc; v1 = v1 * sc; u32x4 w; w.x = cvt_pk_bf16(v0[0], v0[1]); w.y = cvt_pk_bf16(v0[2], v0[3]); w.z = cvt_pk_bf16(v1[0], v1[1]); w.w = cvt_pk_bf16(v1[2], v1[3]);
                    *(u32x4*)(rowp + bj * HALF) = w; } }
    }
};

struct PanelStats {
    unsigned* xbuf;
    unsigned* cnt;
    unsigned* tmo;
    int ntn; float eps;
    unsigned code;
    __device__ __forceinline__ bool run(const f32x4 (&v)[2][2][4][2], const Unit& u, int wr, int wc, int fr, int fq, PG8_LAS unsigned char* lds, int wid, int lane) const {
        typedef float f32x2v __attribute__((ext_vector_type(2)));
        PG8_LAS f32x2v* P = (PG8_LAS f32x2v*)lds;
        PG8_LAS f32x2v* S = (PG8_LAS f32x2v*)(lds + 8192);
        PG8_LAS unsigned* flag = (PG8_LAS unsigned*)(lds + 8192 + 2048);
#pragma unroll
        for (int ai = 0; ai < 2; ++ai)
#pragma unroll
            for (int m = 0; m < 4; ++m) {
                float s = 0.f;
#pragma unroll
                for (int bj = 0; bj < 2; ++bj)
#pragma unroll
                    for (int n = 0; n < 2; ++n) { const f32x4 x = v[ai][bj][m][n]; s += (x[0] + x[1]) + (x[2] + x[3]); }
                s += __shfl_xor(s, 16); s += __shfl_xor(s, 32);
                const float mw = s * (1.0f / 64.0f); float q = 0.f;
#pragma unroll
                for (int bj = 0; bj < 2; ++bj)
#pragma unroll
                    for (int n = 0; n < 2; ++n) { const f32x4 d = v[ai][bj][m][n] - mw; q += (d[0] * d[0] + d[1] * d[1]) + (d[2] * d[2] + d[3] * d[3]); }
                q += __shfl_xor(q, 16); q += __shfl_xor(q, 32);
                if (fq == 0) P[(ai * HALF + wr * 64 + m * 16 + fr) * 4 + wc] = (f32x2v){mw, q};
            }
        asm volatile("s_waitcnt lgkmcnt(0)" ::: "memory"); __builtin_amdgcn_s_barrier(); asm volatile("" ::: "memory");
#if defined(BROKEN_EXCHANGE_NO_WAIT)
#warning BROKEN CONTROL BUILD: the row-statistics exchange does not wait; results are wrong by design
        if (blockIdx.x >= 64) { const long long t0_ = clock64(); while (clock64() - t0_ < 60000) __builtin_amdgcn_s_sleep(8); }
#endif
        const int row = wid * 32 + (lane & 31);
        if (lane < 32) {
            const f32x2v a = P[row * 4 + 0], b = P[row * 4 + 1], c = P[row * 4 + 2], d = P[row * 4 + 3];
            const float mt = (a.x + b.x + c.x + d.x) * 0.25f;
            const float da = a.x - mt, db = b.x - mt, dc = c.x - mt, dd = d.x - mt;
            const float m2 = (a.y + b.y) + (c.y + d.y) + 64.0f * ((da * da + db * db) + (dc * dc + dd * dd));
            unsigned long long* slot = (unsigned long long*)xbuf + ((size_t)(u.pm * BM + row) * 4 + u.pn);
            __hip_atomic_store(slot, ((unsigned long long)__float_as_uint(m2) << 32) | __float_as_uint(mt), __ATOMIC_RELAXED, __HIP_MEMORY_SCOPE_AGENT);
        }
        asm volatile("s_waitcnt vmcnt(0)" ::: "memory");
        if (lane == 0) __hip_atomic_fetch_add(cnt + 64 * u.pm, 1u, __ATOMIC_RELAXED, __HIP_MEMORY_SCOPE_AGENT);
        if (wid == 0) {
            bool dead = false; const unsigned long long t0 = __builtin_amdgcn_s_memrealtime(); const unsigned want = 8u * (unsigned)ntn;
            for (;;) {
#if defined(BROKEN_EXCHANGE_NO_WAIT)
                break;
#endif
                if ((unsigned)__builtin_amdgcn_readfirstlane(__hip_atomic_load(cnt + 64 * u.pm, __ATOMIC_RELAXED, __HIP_MEMORY_SCOPE_AGENT)) >= want) break;
                if (__builtin_amdgcn_s_memrealtime() - t0 > 2000000ull) {
                    if (lane == 0) { unsigned expect = 0u; __hip_atomic_compare_exchange_strong(tmo + 1, &expect, code | (unsigned)(u.pm & 0xff), __ATOMIC_RELAXED, __ATOMIC_RELAXED, __HIP_MEMORY_SCOPE_AGENT);
                                     __hip_atomic_store(tmo, 1u, __ATOMIC_RELAXED, __HIP_MEMORY_SCOPE_AGENT); }
                    dead = true; break; }
                __builtin_amdgcn_s_sleep(2);
            }
            __builtin_amdgcn_fence(__ATOMIC_ACQUIRE, "agent");
            if (lane == 0) flag[0] = dead ? 1u : 0u;
        }
        asm volatile("s_waitcnt vmcnt(0) lgkmcnt(0)" ::: "memory"); __builtin_amdgcn_s_barrier(); asm volatile("" ::: "memory");
        const bool bad = flag[0] != 0u;
        if (lane < 32) {
            const unsigned long long* slot = (const unsigned long long*)xbuf + (size_t)(u.pm * BM + row) * 4; float mt[4], m2[4]; float ms = 0.f;
#pragma unroll
            for (int t = 0; t < 4; ++t) { if (t < ntn) { const unsigned long long w = __hip_atomic_load(slot + t, __ATOMIC_RELAXED, __HIP_MEMORY_SCOPE_AGENT); mt[t] = __uint_as_float((unsigned)w); m2[t] = __uint_as_float((unsigned)(w >> 32)); } else { mt[t] = 0.f; m2[t] = 0.f; } ms += mt[t]; }
            const float mean = ms / (float)ntn; float q = 0.f;
#pragma unroll
            for (int t = 0; t < 4; ++t) if (t < ntn) { const float dm = mt[t] - mean; q += m2[t] + 256.0f * dm * dm; }
            S[row] = (f32x2v){mean, 1.0f / sqrtf(q / (256.0f * (float)ntn) + eps)};
        }
        asm volatile("s_waitcnt lgkmcnt(0)" ::: "memory"); __builtin_amdgcn_s_barrier(); asm volatile("" ::: "memory");
        return bad;
    }
};
struct EpiLnRes {
    static constexpr bool PERM = false, AFTER_DRAIN = true;
    const float* base; float* out; int ldc; const float* bias; PanelStats st; unsigned poison;
    __device__ __forceinline__ void fused(f32x4 (&acc)[2][2][4][2], const Unit& u, int wr, int wc, int fr, int fq, PG8_LAS unsigned char* lds, int wid, int lane) const {
        typedef float f32x2v __attribute__((ext_vector_type(2)));
        const PG8_LAS f32x2v* S = (const PG8_LAS f32x2v*)(lds + 8192);
        const int col0 = u.pn * BM + wc * 32 + 4 * fq;
#pragma unroll
        for (int bj = 0; bj < 2; ++bj)
#pragma unroll
            for (int n = 0; n < 2; ++n) { const f32x4 bv = bias ? *(const f32x4*)(bias + col0 + bj * HALF + n * 16) : (f32x4){0.f, 0.f, 0.f, 0.f};
#pragma unroll
                for (int ai = 0; ai < 2; ++ai)
#pragma unroll
                    for (int m = 0; m < 4; ++m) acc[ai][bj][m][n] += bv; }
        f32x4 pre[4][2][2];
#pragma unroll
        for (int m = 0; m < 4; ++m) { const size_t off = (size_t)(u.pm * BM + wr * 64 + m * 16 + fr) * ldc + col0;
#pragma unroll
            for (int bj = 0; bj < 2; ++bj)
#pragma unroll
                for (int n = 0; n < 2; ++n) pre[m][bj][n] = *(const f32x4*)(base + off + bj * HALF + n * 16); }
        const bool bad = st.run(acc, u, wr, wc, fr, fq, lds, wid, lane) || poison != 0u;
        const float qnan = __builtin_nanf("");
#pragma unroll
        for (int ai = 0; ai < 2; ++ai)
#pragma unroll
            for (int m = 0; m < 4; ++m) { const int r = ai * HALF + wr * 64 + m * 16 + fr; const f32x2v sr = S[r]; const size_t off = (size_t)(u.pm * BM + r) * ldc + col0;
#pragma unroll
                for (int bj = 0; bj < 2; ++bj)
#pragma unroll
                    for (int n = 0; n < 2; ++n) { const f32x4 bs = ai == 0 ? pre[m][bj][n] : *(const f32x4*)(base + off + bj * HALF + n * 16); f32x4 o = bs + (acc[ai][bj][m][n] - sr.x) * sr.y;
                        if (bad) o = (f32x4){qnan, qnan, qnan, qnan}; *(f32x4*)(out + off + bj * HALF + n * 16) = o; }
                if (m & 1) asm volatile("" ::: "memory"); }
    }
};
struct EpiLnResLn {
    static constexpr bool PERM = false, AFTER_DRAIN = true;
    const float* base; float* out; bf16_t* xn; int ldc; const float* bias; PanelStats st1, st2; unsigned poison;
    __device__ __forceinline__ void fused(f32x4 (&acc)[2][2][4][2], const Unit& u, int wr, int wc, int fr, int fq, PG8_LAS unsigned char* lds, int wid, int lane) const {
        typedef float f32x2v __attribute__((ext_vector_type(2))); typedef unsigned u32x2v __attribute__((ext_vector_type(2)));
        const PG8_LAS f32x2v* S = (const PG8_LAS f32x2v*)(lds + 8192);
        const int col0 = u.pn * BM + wc * 32 + 4 * fq;
#pragma unroll
        for (int bj = 0; bj < 2; ++bj)
#pragma unroll
            for (int n = 0; n < 2; ++n) { const f32x4 bv = bias ? *(const f32x4*)(bias + col0 + bj * HALF + n * 16) : (f32x4){0.f, 0.f, 0.f, 0.f};
#pragma unroll
                for (int ai = 0; ai < 2; ++ai)
#pragma unroll
                    for (int m = 0; m < 4; ++m) acc[ai][bj][m][n] += bv; }
        bool bad = st1.run(acc, u, wr, wc, fr, fq, lds, wid, lane) || poison != 0u;
        const float qnan = __builtin_nanf("");
#pragma unroll
        for (int ai = 0; ai < 2; ++ai)
#pragma unroll
            for (int m = 0; m < 4; ++m) { const int r = ai * HALF + wr * 64 + m * 16 + fr; const f32x2v sr = S[r]; const size_t off = (size_t)(u.pm * BM + r) * ldc + col0;
#pragma unroll
                for (int bj = 0; bj < 2; ++bj)
#pragma unroll
                    for (int n = 0; n < 2; ++n) { const f32x4 bs = *(const f32x4*)(base + off + bj * HALF + n * 16); acc[ai][bj][m][n] = bs + (acc[ai][bj][m][n] - sr.x) * sr.y; }
                asm volatile("" : "+v"(acc[ai][0][m][0]), "+v"(acc[ai][0][m][1]), "+v"(acc[ai][1][m][0]), "+v"(acc[ai][1][m][1]));
                if (m & 1) asm volatile("" ::: "memory"); }
        const bool bad1 = bad;
        bad = st2.run(acc, u, wr, wc, fr, fq, lds, wid, lane) || bad;
#pragma unroll
        for (int ai = 0; ai < 2; ++ai)
#pragma unroll
            for (int m = 0; m < 4; ++m) { const int r = ai * HALF + wr * 64 + m * 16 + fr; const f32x2v sr = S[r]; const size_t off = (size_t)(u.pm * BM + r) * ldc + col0;
#pragma unroll
                for (int bj = 0; bj < 2; ++bj)
#pragma unroll
                    for (int n = 0; n < 2; ++n) { const f32x4 x1 = acc[ai][bj][m][n]; *(f32x4*)(out + off + bj * HALF + n * 16) = bad1 ? (f32x4){qnan, qnan, qnan, qnan} : x1;
                        const f32x4 o = (x1 - sr.x) * sr.y; u32x2v w; w.x = cvt_pk_bf16(o[0], o[1]); w.y = cvt_pk_bf16(o[2], o[3]);
                        if (bad) { w.x = 0x7fc07fc0u; w.y = 0x7fc07fc0u; } *(u32x2v*)(xn + off + bj * HALF + n * 16) = w; }
                asm volatile("" ::: "memory"); }
    }
};

template <class Epi, class Sched, bool ALIGN_EPI = false, bool SP2 = false>
__device__ __forceinline__ void gemm_phase(PG8_LAS unsigned char* lds, const Gemm g, const Sched& S, const Epi& E) {
    const int tid = threadIdx.x, wid = __builtin_amdgcn_readfirstlane(tid >> 6), lane = tid & 63, wr = wid >> 2, wc = wid & 3, fr = lane & 15, fq = lane >> 4;
    const int K = g.K, nt = K / BK;
    unsigned voffA[2], voffB[2];
#pragma unroll
    for (int i = 0; i < 2; ++i) { int R, C; stage_rc(tid * 16 + i * 8192, R, C); const int Rb = Epi::PERM ? ((R & ~31) + perm32(R & 31)) : R;
        voffA[i] = (unsigned)(R * K + C) * 2u; voffB[i] = (unsigned)(Rb * K + C) * 2u; }
    const size_t kstep = (size_t)(BK * 2);
    const size_t hstep = (size_t)HALF * K * 2;
    const size_t tstep = 2 * hstep;
    const unsigned ldsw = (unsigned)wid * 1024u;
    const int aoff = lds_byte(wr * 64 + fr, fq * 8), boff = lds_byte(wc * 32 + fr, fq * 8);
#define PG8_SA(b, h) (((b) * 2 + (h)) * HTB)
#define PG8_SB(b, h) ((4 + (b) * 2 + (h)) * HTB)
#define PG8_STAGE(bufoff, gbase, voff) do { _Pragma("unroll") for (int _i = 0; _i < 2; ++_i) \
        __builtin_amdgcn_global_load_lds((const unsigned*)((const char*)(gbase) + (voff)[_i]), (PG8_LAS unsigned*)(lds + (bufoff) + ldsw + _i * 8192), 16, 0, 0); } while (0)
#define PG8_LDA(dst, b, h) do { _Pragma("unroll") for (int m = 0; m < 4; ++m) _Pragma("unroll") for (int k = 0; k < 2; ++k) dst[m][k] = *(const PG8_LAS bf16x8*)(lds + PG8_SA(b, h) + aoff + m * 2048 + k * 1024); } while (0)
#define PG8_LDB(dst, b, h) do { _Pragma("unroll") for (int n = 0; n < 2; ++n) _Pragma("unroll") for (int k = 0; k < 2; ++k) dst[n][k] = *(const PG8_LAS bf16x8*)(lds + PG8_SB(b, h) + boff + n * 2048 + k * 1024); } while (0)
#define PG8_MMA(ai, bj, At, Bt) do { __builtin_amdgcn_s_setprio(1); _Pragma("unroll") for (int m = 0; m < 4; ++m) _Pragma("unroll") for (int n = 0; n < 2; ++n) _Pragma("unroll") for (int k = 0; k < 2; ++k) \
        acc[ai][bj][m][n] = __builtin_amdgcn_mfma_f32_16x16x32_bf16(Bt[n][k], At[m][k], acc[ai][bj][m][n], 0, 0, 0); __builtin_amdgcn_s_setprio(0); } while (0)
#define PG8_WAIT_V(n) asm volatile("s_waitcnt vmcnt(" #n ")" ::: "memory")
#define PG8_WAIT_L(n) asm volatile("s_waitcnt lgkmcnt(" #n ")" ::: "memory")
#define PG8_BAR __builtin_amdgcn_s_barrier()
#define PG8_SCHED __builtin_amdgcn_sched_barrier(0)
    Unit cur, nxt; int ui = 0;
    if (!S.next(0, cur)) return;
    f32x4 acc[2][2][4][2];
#pragma unroll
    for (int a = 0; a < 2; ++a)
#pragma unroll
        for (int b = 0; b < 2; ++b)
#pragma unroll
            for (int m = 0; m < 4; ++m)
#pragma unroll
                for (int n = 0; n < 2; ++n) acc[a][b][m][n] = (f32x4){0.f, 0.f, 0.f, 0.f};
    bf16x8 At[4][2], B0[2][2], B1[2][2];
    const char* cA = (const char*)g.A + (size_t)cur.pm * tstep; const char* cB = (const char*)g.Bt + (size_t)cur.pn * tstep;
    S.a_ready(cur);
    if constexpr (SP2) {
        PG8_STAGE(PG8_SB(0, 0), cB, voffB); PG8_STAGE(PG8_SB(0, 1), cB + hstep, voffB); PG8_STAGE(PG8_SA(0, 0), cA, voffA); PG8_STAGE(PG8_SA(0, 1), cA + hstep, voffA);
        if (wr == 1) PG8_BAR;
        PG8_WAIT_V(2); PG8_BAR;
        PG8_STAGE(PG8_SB(1, 0), cB + kstep, voffB); PG8_STAGE(PG8_SA(1, 0), cA + kstep, voffA); PG8_STAGE(PG8_SB(1, 1), cB + hstep + kstep, voffB);
        PG8_WAIT_V(6); PG8_BAR;
    } else {
        PG8_STAGE(PG8_SB(0, 0), cB, voffB); PG8_STAGE(PG8_SA(0, 0), cA, voffA); PG8_STAGE(PG8_SB(0, 1), cB + hstep, voffB); PG8_STAGE(PG8_SA(0, 1), cA + hstep, voffA);
        if (wr == 1) PG8_BAR;
        PG8_WAIT_V(4); PG8_BAR;
        PG8_STAGE(PG8_SB(1, 0), cB + kstep, voffB); PG8_STAGE(PG8_SA(1, 0), cA + kstep, voffA); PG8_STAGE(PG8_SB(1, 1), cB + hstep + kstep, voffB);
        PG8_WAIT_V(6); PG8_BAR;
    }
    for (;;) {
        const bool has_next = S.next(ui + 1, nxt);
        const char* nA = has_next ? (const char*)g.A + (size_t)nxt.pm * tstep : cA; const char* nB = has_next ? (const char*)g.Bt + (size_t)nxt.pn * tstep : cB;
        for (int t = 0; t < nt; t += 2) {
            const bool last = (t == nt - 2);
            const char* a1 = cA + (size_t)(t + 1) * kstep;
            const char* a2 = last ? nA : cA + (size_t)(t + 2) * kstep; const char* b2 = last ? nB : cB + (size_t)(t + 2) * kstep;
            const char* a3 = a2 + kstep; const char* b3 = b2 + kstep;
            if (last && has_next) S.a_ready(nxt);
            if constexpr (SP2) {
            PG8_LDB(B0, 0, 0); PG8_LDB(B1, 0, 1); PG8_SCHED; PG8_LDA(At, 0, 0); PG8_STAGE(PG8_SA(1, 1), a1 + hstep, voffA);
            PG8_WAIT_V(8); PG8_WAIT_L(0); PG8_BAR; PG8_MMA(0, 0, At, B0); PG8_MMA(0, 1, At, B1); PG8_BAR; PG8_SCHED;
            PG8_LDA(At, 0, 1); PG8_STAGE(PG8_SB(0, 0), b2, voffB); PG8_STAGE(PG8_SB(0, 1), b2 + hstep, voffB); PG8_STAGE(PG8_SA(0, 0), a2, voffA);
            PG8_WAIT_V(8); PG8_WAIT_L(0); PG8_BAR; PG8_MMA(1, 0, At, B0); PG8_MMA(1, 1, At, B1); PG8_BAR; PG8_SCHED;
            PG8_LDB(B0, 1, 0); PG8_LDB(B1, 1, 1); PG8_SCHED; PG8_LDA(At, 1, 0); PG8_STAGE(PG8_SA(0, 1), a2 + hstep, voffA);
            PG8_WAIT_V(8); PG8_WAIT_L(0); PG8_BAR; PG8_MMA(0, 0, At, B0); PG8_MMA(0, 1, At, B1); PG8_BAR; PG8_SCHED;
            PG8_LDA(At, 1, 1); PG8_STAGE(PG8_SB(1, 0), b3, voffB); PG8_STAGE(PG8_SB(1, 1), b3 + hstep, voffB); PG8_STAGE(PG8_SA(1, 0), a3, voffA);
            PG8_WAIT_V(8); PG8_WAIT_L(0); PG8_BAR; PG8_MMA(1, 0, At, B0); PG8_MMA(1, 1, At, B1); PG8_BAR; PG8_SCHED;
            } else {
            PG8_LDB(B0, 0, 0); PG8_SCHED; PG8_LDA(At, 0, 0); PG8_STAGE(PG8_SA(1, 1), a1 + hstep, voffA);
            PG8_WAIT_L(8); PG8_BAR; PG8_WAIT_L(0); PG8_MMA(0, 0, At, B0); PG8_BAR; PG8_SCHED;
            PG8_LDB(B1, 0, 1); PG8_STAGE(PG8_SB(0, 0), b2, voffB);
            PG8_BAR; PG8_WAIT_L(0); PG8_MMA(0, 1, At, B1); PG8_BAR;
            PG8_LDA(At, 0, 1); PG8_STAGE(PG8_SA(0, 0), a2, voffA);
            PG8_BAR; PG8_WAIT_L(0); PG8_MMA(1, 0, At, B0); PG8_BAR; PG8_SCHED;
            PG8_STAGE(PG8_SB(0, 1), b2 + hstep, voffB);
            PG8_WAIT_V(6); PG8_BAR; PG8_MMA(1, 1, At, B1); PG8_BAR;
            PG8_LDB(B0, 1, 0); PG8_SCHED; PG8_LDA(At, 1, 0); PG8_STAGE(PG8_SA(0, 1), a2 + hstep, voffA);
            PG8_WAIT_L(8); PG8_BAR; PG8_WAIT_L(0); PG8_MMA(0, 0, At, B0); PG8_BAR; PG8_SCHED;
            PG8_LDB(B1, 1, 1); PG8_STAGE(PG8_SB(1, 0), b3, voffB);
            PG8_BAR; PG8_WAIT_L(0); PG8_MMA(0, 1, At, B1); PG8_BAR;
            PG8_LDA(At, 1, 1); PG8_STAGE(PG8_SA(1, 0), a3, voffA);
            PG8_BAR; PG8_WAIT_L(0); PG8_MMA(1, 0, At, B0); PG8_BAR; PG8_SCHED;
            PG8_STAGE(PG8_SB(1, 1), b3 + hstep, voffB);
            PG8_WAIT_V(6); PG8_BAR; PG8_MMA(1, 1, At, B1); PG8_BAR;
            }
        }
        if constexpr (ALIGN_EPI) { if (wr == 0) PG8_BAR; }
        if constexpr (!Epi::AFTER_DRAIN) { E(acc, cur, wr, wc, fr, fq); S.done(cur); }
        if (!has_next) break;
#pragma unroll
        for (int a = 0; a < 2; ++a)
#pragma unroll
            for (int b = 0; b < 2; ++b)
#pragma unroll
                for (int m = 0; m < 4; ++m)
#pragma unroll
                    for (int n = 0; n < 2; ++n) acc[a][b][m][n] = (f32x4){0.f, 0.f, 0.f, 0.f};
        cur = nxt; cA = nA; cB = nB; ++ui;
        if constexpr (ALIGN_EPI) { if (wr == 1) PG8_BAR; }
    }
    PG8_WAIT_V(0);
    if constexpr (!ALIGN_EPI) { if (wr == 0) PG8_BAR; }
    PG8_BAR;
    if constexpr (Epi::AFTER_DRAIN) { E.fused(acc, cur, wr, wc, fr, fq, lds, wid, lane); S.done(cur); }
#undef PG8_SA
#undef PG8_SB
#undef PG8_STAGE
#undef PG8_LDA
#undef PG8_LDB
#undef PG8_MMA
#undef PG8_WAIT_V
#undef PG8_WAIT_L
#undef PG8_BAR
#undef PG8_SCHED
}
}

#define DI __device__ __forceinline__
#define LAS __attribute__((address_space(3)))
typedef unsigned short bf16;
typedef pg8::f32x4 f32x4;
typedef pg8::bf16x8 bf16x8;
typedef pg8::u32x4 u32x4;
typedef float f32x16 __attribute__((ext_vector_type(16)));
typedef float f32x2_t __attribute__((ext_vector_type(2)));
typedef __bf16 bf16x2_t __attribute__((ext_vector_type(2)));
typedef unsigned u32x2 __attribute__((ext_vector_type(2)));
#define MFMA32(a, b, c) __builtin_amdgcn_mfma_f32_32x32x16_bf16((a), (b), (c), 0, 0, 0)

#ifndef MK_PER_PHASE
#define MK_PER_PHASE 0
#endif

constexpr int MP = 16384, MS = 256, M = MP + MS, D = 1024, FF = 2688, NGLA = 3072, NCH = 288, SEQ = 2048;
constexpr float EPS = 1e-6f;
constexpr int NPHASE = 16;
constexpr size_t MiB = 1u << 20;
constexpr size_t WS_SSQ = 0;
constexpr size_t WS_ELAST = 1 * MiB;
constexpr size_t W_FI = 2 * MiB;
constexpr size_t W_FO = W_FI + 42 * MiB;
constexpr size_t W_GI = W_FO + 21 * MiB;
constexpr size_t W_GO = W_GI + 6 * MiB;
constexpr size_t W_KV = W_GO + 2 * MiB;
constexpr size_t W_Q = W_KV + 1 * MiB;
constexpr size_t W_AO = W_Q + 1536 * 1024;
constexpr size_t W_GLR = W_AO + 1536 * 1024;
constexpr size_t W_ROPE = W_GLR + 65536;
constexpr size_t WS_XB = 78 * MiB;
constexpr size_t WS_U1 = 111 * MiB;
constexpr size_t WS_U2 = 209 * MiB;
constexpr size_t WS_U3 = 299 * MiB;
constexpr size_t WS_LSE = 332 * MiB;
constexpr size_t WS_END = 333 * MiB;
static_assert(W_ROPE + 2056 * 32 * 8 <= WS_XB, "ws map");
constexpr size_t O_Y = 0, O_SP = (size_t)M * D, O_SS = O_SP + 1048576, O_KP = O_SS + 4194304, O_VP = O_KP + 4194304, O_KS = O_VP + 4194304, O_VS = O_KS + 65536;

constexpr int LDS_BYTES = 147456;

struct Args { const float* in[19]; float* out; unsigned char* ws; int ph_lo, ph_hi; };

DI float bf2f(bf16 b) { return __uint_as_float((unsigned)b << 16); }
DI unsigned cvtpk(float lo, float hi) { f32x2_t v = {lo, hi}; bf16x2_t b = __builtin_convertvector(v, bf16x2_t); return __builtin_bit_cast(unsigned, b); }
DI bf16 f2bf(float f) { return (bf16)(cvtpk(f, 0.f) & 0xffffu); }
DI float wave_sum(float v) {
#pragma unroll
    for (int o = 1; o < 64; o <<= 1) v += __shfl_xor(v, o);
    return v;
}
DI float wave_max(float v) {
#pragma unroll
    for (int o = 1; o < 64; o <<= 1) v = fmaxf(v, __shfl_xor(v, o));
    return v;
}
DI int swz(int x) { return (x & ~12) | ((x & 4) << 1) | ((x & 8) >> 1); }
DI int crow(int reg, int h) { return (reg & 3) + 8 * (reg >> 2) + 4 * h; }
template <int S> DI bf16x8 pack8(const f32x16& x) {
    u32x4 p; p.x = cvtpk(x[8 * S], x[8 * S + 1]); p.y = cvtpk(x[8 * S + 2], x[8 * S + 3]); p.z = cvtpk(x[8 * S + 4], x[8 * S + 5]); p.w = cvtpk(x[8 * S + 6], x[8 * S + 7]);
    return __builtin_bit_cast(bf16x8, p);
}
DI float silu(float x) { return x / (1.f + __expf(-x)); }

struct EpiSwiGLU {
    static constexpr bool PERM = false, AFTER_DRAIN = false;
    bf16* O; const float* ssq;
    DI void operator()(const f32x4 (&acc)[2][2][4][2], const pg8::Unit& u, int wr, int wc, int fr, int fq) const {
#pragma unroll
        for (int ai = 0; ai < 2; ++ai)
#pragma unroll
            for (int m = 0; m < 4; ++m) {
                const int row = u.pm * 256 + ai * 128 + wr * 64 + m * 16 + fr;
                const float rstd = rsqrtf(ssq[row] * (1.f / D) + EPS);
#pragma unroll
                for (int bj = 0; bj < 2; ++bj) {
                    const f32x4 g = acc[ai][bj][m][0] * rstd, uu = acc[ai][bj][m][1] * rstd;
                    u32x2 w; w.x = cvtpk(silu(g[0]) * uu[0], silu(g[1]) * uu[1]); w.y = cvtpk(silu(g[2]) * uu[2], silu(g[3]) * uu[3]);
                    *(u32x2*)(O + (size_t)row * FF + u.pn * 128 + bj * 64 + wc * 16 + fq * 4) = w;
                }
            }
    }
};
struct EpiResid {
    static constexpr bool PERM = false, AFTER_DRAIN = false;
    float* X; bf16* XB; float* ssq_out; float scale;
    DI void operator()(const f32x4 (&acc)[2][2][4][2], const pg8::Unit& u, int wr, int wc, int fr, int fq) const {
#pragma unroll
        for (int ai = 0; ai < 2; ++ai)
#pragma unroll
            for (int m = 0; m < 4; ++m) {
                const int row = u.pm * 256 + ai * 128 + wr * 64 + m * 16 + fr;
                float ss = 0.f;
#pragma unroll
                for (int bj = 0; bj < 2; ++bj)
#pragma unroll
                    for (int n = 0; n < 2; ++n) {
                        const size_t off = (size_t)row * D + u.pn * 256 + bj * 128 + wc * 32 + n * 16 + fq * 4;
                        f32x4 v = *(const f32x4*)(X + off) + acc[ai][bj][m][n] * scale;
                        *(f32x4*)(X + off) = v;
                        ss += (v[0] * v[0] + v[1] * v[1]) + (v[2] * v[2] + v[3] * v[3]);
                        if (XB) { u32x2 w; w.x = cvtpk(v[0], v[1]); w.y = cvtpk(v[2], v[3]); *(u32x2*)(XB + off) = w; }
                    }
                if (ssq_out) { ss += __shfl_xor(ss, 16); ss += __shfl_xor(ss, 32); if (fq == 0) atomicAdd(ssq_out + row, ss); }
                asm volatile("" ::: "memory");
            }
    }
};
struct EpiScale {
    static constexpr bool PERM = false, AFTER_DRAIN = false;
    bf16* Ob; float* Of; int ldc; const float* ssq;
    DI void operator()(const f32x4 (&acc)[2][2][4][2], const pg8::Unit& u, int wr, int wc, int fr, int fq) const {
#pragma unroll
        for (int ai = 0; ai < 2; ++ai)
#pragma unroll
            for (int m = 0; m < 4; ++m) {
                const int row = u.pm * 256 + ai * 128 + wr * 64 + m * 16 + fr;
                const float rstd = rsqrtf(ssq[row] * (1.f / D) + EPS);
#pragma unroll
                for (int bj = 0; bj < 2; ++bj)
#pragma unroll
                    for (int n = 0; n < 2; ++n) {
                        const size_t off = (size_t)row * ldc + u.pn * 256 + bj * 128 + wc * 32 + n * 16 + fq * 4;
                        const f32x4 v = acc[ai][bj][m][n] * rstd;
                        if (Ob) { u32x2 w; w.x = cvtpk(v[0], v[1]); w.y = cvtpk(v[2], v[3]); *(u32x2*)(Ob + off) = w; }
                        else *(f32x4*)(Of + off) = v;
                    }
            }
    }
};

template <int MODE> DI int src_col(int n) {
    if (MODE == 1) { const int G = n >> 5, w = n & 31; return w < 16 ? G * 16 + w : FF + G * 16 + (w - 16); }
    if (MODE == 2) return n < 2048 ? n : n + 16;
    return n;
}
template <int MODE> DI void transpose_item(const float* W, int K, int ldw, int Ndst, bf16* WT, const float* gain, LAS float* scr, int item, int lane) {
    const int nblk = Ndst / 32, kb = item / nblk, nb = item % nblk, k0 = 64 * kb, n0 = 32 * nb;
    const int sc = src_col<MODE>(n0 + (lane & 31));
#pragma unroll 8
    for (int i = 0; i < 32; ++i) { const int kk = 2 * i + (lane >> 5); const float g = gain ? gain[k0 + kk] : 1.f; scr[kk * 33 + (lane & 31)] = W[(size_t)(k0 + kk) * ldw + sc] * g; }
    asm volatile("s_waitcnt lgkmcnt(0)" ::: "memory");
    const int c = lane & 7;
#pragma unroll
    for (int j = 0; j < 4; ++j) { const int n = (lane >> 3) + 8 * j; const LAS float* s = scr + (8 * c) * 33 + n;
        u32x4 o; o.x = cvtpk(s[0 * 33], s[1 * 33]); o.y = cvtpk(s[2 * 33], s[3 * 33]); o.z = cvtpk(s[4 * 33], s[5 * 33]); o.w = cvtpk(s[6 * 33], s[7 * 33]);
        *(u32x4*)(WT + (size_t)(n0 + n) * K + k0 + 8 * c) = o; }
    asm volatile("s_waitcnt lgkmcnt(0)" ::: "memory");
}

DI void p0_prologue(const Args& a, LAS unsigned char* lds, int tid, int lane, int wave) {
    unsigned char* ws = a.ws;
    LAS float* scr = (LAS float*)(lds + wave * 16384);
    const int G = gridDim.x, gw = blockIdx.x * 8 + wave, NGW = G * 8;
    const float* gains = a.in[5];
    constexpr int I_FI = 16 * 168, I_FO = 42 * 32, I_GI = 16 * 96, I_GO = 16 * 32, I_KV = 16 * 16, I_Q = 16 * 24, I_AO = 12 * 32;
    constexpr int NITEMS = 4 * I_FI + 4 * I_FO + I_GI + I_GO + I_KV + I_Q + I_AO;
    for (int it = gw; it < NITEMS; it += NGW) {
        int r = it;
        if (r < 4 * I_FI) { const int mi = r / I_FI, l = mi >> 1, i = mi & 1; transpose_item<1>(a.in[6] + (size_t)mi * D * 2 * FF, D, 2 * FF, 2 * FF, (bf16*)(ws + W_FI) + (size_t)mi * 2 * FF * D, gains + (l * 3 + (i ? 2 : 0)) * D, scr, r % I_FI, lane); continue; } r -= 4 * I_FI;
        if (r < 4 * I_FO) { const int mi = r / I_FO; transpose_item<0>(a.in[7] + (size_t)mi * FF * D, FF, D, D, (bf16*)(ws + W_FO) + (size_t)mi * D * FF, nullptr, scr, r % I_FO, lane); continue; } r -= 4 * I_FO;
        if (r < I_GI) { transpose_item<2>(a.in[8], D, 3088, NGLA, (bf16*)(ws + W_GI), gains + 1 * D, scr, r, lane); continue; } r -= I_GI;
        if (r < I_GO) { transpose_item<0>(a.in[12], D, D, D, (bf16*)(ws + W_GO), nullptr, scr, r, lane); continue; } r -= I_GO;
        if (r < I_KV) { transpose_item<0>(a.in[14], D, 512, 512, (bf16*)(ws + W_KV), a.in[13], scr, r, lane); continue; } r -= I_KV;
        if (r < I_Q) { transpose_item<0>(a.in[16], D, 768, 768, (bf16*)(ws + W_Q), gains + 4 * D, scr, r, lane); continue; } r -= I_Q;
        transpose_item<0>(a.in[18], 768, D, D, (bf16*)(ws + W_AO), nullptr, scr, r, lane);
    }
    float* ssq = (float*)(ws + WS_SSQ);
    for (int m = gw; m < M; m += NGW) {
        const float* xr = m < MP ? a.in[0] + (size_t)m * D : a.in[1] + (size_t)(m - MP) * D;
        float s = 0.f;
#pragma unroll
        for (int j = 0; j < 4; ++j) {
            const f32x4 v = *((const f32x4*)xr + lane + 64 * j);
            *((f32x4*)(a.out + (size_t)m * D) + lane + 64 * j) = v;
            u32x2 w; w.x = cvtpk(v[0], v[1]); w.y = cvtpk(v[2], v[3]);
            *((u32x2*)((bf16*)(ws + WS_XB) + (size_t)m * D) + lane + 64 * j) = w;
            s += (v[0] * v[0] + v[1] * v[1]) + (v[2] * v[2] + v[3] * v[3]);
        }
        s = wave_sum(s);
        if (lane == 0) ssq[m] = s;
    }
    const int gt = blockIdx.x * 512 + tid, NGT = G * 512;
    for (int i = gt; i < 5 * M; i += NGT) ssq[M + i] = 0.f;
    for (int i = gt; i < 2056 * 32; i += NGT) {
        const int p = i >> 5, f = i & 31; const int pos = p < 2048 ? p : 8192 + (p - 2048);
        const double inv = pow(10000.0, -(double)f / 32.0); double sn, cs; sincos((double)pos * inv, &sn, &cs);
        ((float*)(ws + W_ROPE))[2 * i] = (float)cs; ((float*)(ws + W_ROPE))[2 * i + 1] = (float)sn;
    }
    for (int i = gt; i < 32 * D; i += NGT) { const int c = i >> 10, k = i & 1023; ((bf16*)(ws + W_GLR))[i] = c < 16 ? f2bf(a.in[8][(size_t)k * 3088 + 2048 + c] * gains[1 * D + k]) : (bf16)0; }
}

constexpr size_t U2_QIMG = 0, U2_PBE = 18 * MiB, U2_KDIMG = 36 * MiB, U2_VT = 54 * MiB;
constexpr int PBE_BYTES = 7168;
DI float logsig16(float z) { return -(fmaxf(-z, 0.f) + __logf(1.f + __expf(-fabsf(z)))) * (1.f / 16.f); }
DI void gla_prep(const Args& a, LAS unsigned char* lds, int tid, int lane, int wave) {
    unsigned char* ws = a.ws;
    LAS unsigned char* QI = lds;
    LAS unsigned char* KI = lds + 65536;
    LAS float* glr = (LAS float*)(lds + 131072);
    const bf16* qkvr = (const bf16*)(ws + WS_U1);
    const bf16* XBp = (const bf16*)(ws + WS_XB);
    const bf16* WgT = (const bf16*)(ws + W_GLR);
    unsigned char* QIMG = ws + WS_U2 + U2_QIMG; unsigned char* PBE = ws + WS_U2 + U2_PBE; unsigned char* KDIMG = ws + WS_U2 + U2_KDIMG; bf16* VT = (bf16*)(ws + WS_U2 + U2_VT);
    const float* ssq1 = (const float*)(ws + WS_SSQ) + 1 * M;
    const int r = lane & 31, hh = lane >> 5;
    for (int ch = blockIdx.x; ch < NCH; ch += gridDim.x) {
        const bool smp = ch >= 256; const int T = smp ? 8 : 64; const int row0 = smp ? MP + 8 * (ch - 256) : 64 * ch;
        {
            f32x16 P0, P1;
#pragma unroll
            for (int i = 0; i < 16; ++i) { P0[i] = 0.f; P1[i] = 0.f; }
            const bf16* x0 = XBp + (size_t)(row0 + r) * D + 128 * wave + 8 * hh;
            const bf16* wg = WgT + (size_t)r * D + 128 * wave + 8 * hh;
#pragma unroll
            for (int ks = 0; ks < 8; ++ks) {
                const bf16x8 bw = *(const bf16x8*)(wg + 16 * ks);
                P0 = MFMA32(*(const bf16x8*)(x0 + 16 * ks), bw, P0);
                P1 = MFMA32(*(const bf16x8*)(x0 + (size_t)32 * D + 16 * ks), bw, P1);
            }
            LAS float* part = (LAS float*)QI + wave * 1024;
            if (r < 16) {
#pragma unroll
                for (int i = 0; i < 16; ++i) { part[crow(i, hh) * 16 + r] = P0[i]; part[(32 + crow(i, hh)) * 16 + r] = P1[i]; }
            }
        }
        __syncthreads();
#pragma unroll
        for (int k2 = 0; k2 < 2; ++k2) {
            const int idx = tid + 512 * k2, t = idx >> 4;
            float sacc = 0.f;
#pragma unroll
            for (int w8 = 0; w8 < 8; ++w8) sacc += ((LAS float*)QI)[w8 * 1024 + idx];
            const float rstd = t < T ? rsqrtf(ssq1[row0 + t] * (1.f / D) + EPS) : 0.f;
            glr[idx] = t < T ? sacc * rstd : 0.f;
        }
        __syncthreads();
        {
            const int col = tid, h = col >> 7, d = col & 127;
            float w2[16];
#pragma unroll
            for (int i = 0; i < 16; ++i) w2[i] = a.in[9][i * 512 + col];
            const float bias = a.in[10][col];
            float total = 0.f;
            for (int t = 0; t < T; ++t) { float z = bias;
#pragma unroll
                for (int i = 0; i < 16; ++i) z += glr[t * 16 + i] * w2[i];
                total += logsig16(z); }
            float cum = 0.f;
            const int dp = swz(d), pc = dp >> 3, wi = dp & 7;
            LAS unsigned char* qi = QI + h * 16384 + wi * 2;
            LAS unsigned char* ki = KI + h * 16384 + wi * 2;
            unsigned char* kdrow = KDIMG + (size_t)(ch * 4 + h) * 16384 + d * 128;
            const int dsw = (d >> 1) & 7;
            for (int t16 = 0; t16 < 4; ++t16) {
                unsigned kd[8];
#pragma unroll
                for (int i = 0; i < 8; ++i) kd[i] = 0u;
                float qv[16], kv[16];
#pragma unroll
                for (int tt = 0; tt < 16; ++tt) { const int t = 16 * t16 + tt; const bool valid = t < T;
                    qv[tt] = valid ? bf2f(qkvr[(size_t)(row0 + t) * NGLA + col]) : 0.f; kv[tt] = valid ? bf2f(qkvr[(size_t)(row0 + t) * NGLA + 512 + col]) : 0.f; }
#pragma unroll
                for (int tt = 0; tt < 16; ++tt) {
                    const int t = 16 * t16 + tt;
                    if (t < T) { float z = bias;
#pragma unroll
                        for (int i = 0; i < 16; ++i) z += glr[t * 16 + i] * w2[i];
                        cum += logsig16(z); }
                    const int off = t * 256 + ((pc ^ tt) << 4);
                    *(LAS bf16*)(qi + off) = f2bf(qv[tt] * 0.08838834764831845f * __expf(cum));
                    *(LAS bf16*)(ki + off) = f2bf(kv[tt] * __expf(-cum));
                    const unsigned kdv = f2bf(kv[tt] * __expf(total - cum));
                    const int p = (tt & ~12) | ((tt & 4) << 1) | ((tt & 8) >> 1);
                    kd[p >> 1] |= kdv << (16 * (p & 1));
                }
                u32x4 o0, o1; o0.x = kd[0]; o0.y = kd[1]; o0.z = kd[2]; o0.w = kd[3]; o1.x = kd[4]; o1.y = kd[5]; o1.z = kd[6]; o1.w = kd[7];
                *(u32x4*)(kdrow + (((2 * t16) ^ dsw) << 4)) = o0; *(u32x4*)(kdrow + (((2 * t16 + 1) ^ dsw) << 4)) = o1;
            }
            *(float*)(PBE + (size_t)(ch * 4 + h) * PBE_BYTES + 6144 + d * 4) = __expf(total);
        }
#pragma unroll 1
        for (int rep = 0; rep < 2; ++rep) {
            const int vc = tid + 512 * rep, h = vc >> 8, vv = vc & 255;
            bf16* vt = VT + ((size_t)(ch * 4 + h) * 256 + vv) * 64;
            for (int t16 = 0; t16 < 4; ++t16) {
                unsigned kd[8];
#pragma unroll
                for (int i = 0; i < 8; ++i) kd[i] = 0u;
#pragma unroll
                for (int tt = 0; tt < 16; ++tt) {
                    const int t = 16 * t16 + tt;
                    const unsigned v = t < T ? (unsigned)qkvr[(size_t)(row0 + t) * NGLA + 1024 + vc] : 0u;
                    const int p = (tt & ~12) | ((tt & 4) << 1) | ((tt & 8) >> 1);
                    kd[p >> 1] |= v << (16 * (p & 1));
                }
                u32x4 o0, o1; o0.x = kd[0]; o0.y = kd[1]; o0.z = kd[2]; o0.w = kd[3]; o1.x = kd[4]; o1.y = kd[5]; o1.z = kd[6]; o1.w = kd[7];
                *(u32x4*)(vt + 16 * t16) = o0; *(u32x4*)(vt + 16 * t16 + 8) = o1;
            }
        }
        __syncthreads();
        {
            const int h = wave >> 1, half = wave & 1;
            const LAS unsigned char* qi = QI + h * 16384; const LAS unsigned char* ki = KI + h * 16384;
            unsigned char* pb = PBE + (size_t)(ch * 4 + h) * PBE_BYTES + lane * 16;
            f32x16 A0, A1;
#pragma unroll
            for (int i = 0; i < 16; ++i) { A0[i] = 0.f; A1[i] = 0.f; }
            if (half == 0) {
#pragma unroll
                for (int s = 0; s < 8; ++s) {
                    const int po = ((2 * s + hh) ^ (r & 15)) << 4;
                    const bf16x8 k0 = *(const LAS bf16x8*)(ki + r * 256 + po);
                    A0 = MFMA32(k0, *(const LAS bf16x8*)(qi + r * 256 + po), A0);
                    A1 = MFMA32(k0, *(const LAS bf16x8*)(qi + (32 + r) * 256 + po), A1);
                }
#pragma unroll
                for (int i = 0; i < 16; ++i) if (crow(i, hh) > r) A0[i] = 0.f;
                *(bf16x8*)(pb + 0 * 1024) = pack8<0>(A0); *(bf16x8*)(pb + 1 * 1024) = pack8<1>(A0);
                *(bf16x8*)(pb + 2 * 1024) = pack8<0>(A1); *(bf16x8*)(pb + 3 * 1024) = pack8<1>(A1);
            } else {
#pragma unroll
                for (int s = 0; s < 8; ++s) {
                    const int po = ((2 * s + hh) ^ (r & 15)) << 4;
                    A0 = MFMA32(*(const LAS bf16x8*)(ki + (32 + r) * 256 + po), *(const LAS bf16x8*)(qi + (32 + r) * 256 + po), A0);
                }
#pragma unroll
                for (int i = 0; i < 16; ++i) if (crow(i, hh) > r) A0[i] = 0.f;
                *(bf16x8*)(pb + 4 * 1024) = pack8<0>(A0); *(bf16x8*)(pb + 5 * 1024) = pack8<1>(A0);
            }
        }
        {
            unsigned char* dst = QIMG + (size_t)ch * 65536;
#pragma unroll
            for (int i = 0; i < 8; ++i) *(u32x4*)(dst + (i * 512 + tid) * 16) = *(const LAS u32x4*)(QI + (i * 512 + tid) * 16);
        }
        __syncthreads();
    }
}

constexpr int REC_SLOT = 40960, REC_SSQ = 81920;
DI void rec_stage(const unsigned char* QIMG, const unsigned char* KDIMG, const unsigned char* PBE, int ch, int h, LAS unsigned char* slot, int tid, int lane, int wave) {
    const unsigned char* q = QIMG + (size_t)(ch * 4 + h) * 16384; const unsigned char* k = KDIMG + (size_t)(ch * 4 + h) * 16384; const unsigned char* p = PBE + (size_t)(ch * 4 + h) * PBE_BYTES;
#pragma unroll
    for (int i = 0; i < 2; ++i) {
        __builtin_amdgcn_global_load_lds((const unsigned*)(q + (i * 512 + tid) * 16), (LAS unsigned*)(slot + i * 8192 + wave * 1024), 16, 0, 0);
        __builtin_amdgcn_global_load_lds((const unsigned*)(k + (i * 512 + tid) * 16), (LAS unsigned*)(slot + 16384 + i * 8192 + wave * 1024), 16, 0, 0);
    }
    if (wave < 7) __builtin_amdgcn_global_load_lds((const unsigned*)(p + tid * 16), (LAS unsigned*)(slot + 32768 + wave * 1024), 16, 0, 0);
}
DI void gla_rec(const Args& a, LAS unsigned char* lds, int tid, int lane, int wave) {
    unsigned char* ws = a.ws;
    LAS float* ssqbuf = (LAS float*)(lds + REC_SSQ);
    const bf16* qkvr = (const bf16*)(ws + WS_U1);
    const unsigned char* QIMG = ws + WS_U2 + U2_QIMG; const unsigned char* PBE = ws + WS_U2 + U2_PBE; const unsigned char* KDIMG = ws + WS_U2 + U2_KDIMG; const bf16* VT = (const bf16*)(ws + WS_U2 + U2_VT);
    bf16* AG = (bf16*)(ws + WS_U3);
    const float* gnorm = a.in[11];
    const int r = lane & 31, hh = lane >> 5, w = wave;
    for (int u = blockIdx.x; u < 160; u += gridDim.x) {
        const bool smp = u >= 32;
        int b, h, nchunk, chunk0, T;
        if (!smp) { b = u >> 2; h = u & 3; nchunk = 32; chunk0 = b * 32; T = 64; }
        else { const int uu = u - 32; b = uu >> 2; h = uu & 3; nchunk = 1; chunk0 = 256 + b; T = 8; }
        rec_stage(QIMG, KDIMG, PBE, chunk0, h, lds, tid, lane, wave);
        f32x16 S[4];
#pragma unroll
        for (int dt = 0; dt < 4; ++dt)
#pragma unroll
            for (int i = 0; i < 16; ++i) S[dt][i] = 0.f;
        if (smp) {
            const float* s0 = a.in[2] + ((size_t)(b * 4 + h) * 128 + 4 * hh) * 256 + 32 * w + r;
#pragma unroll
            for (int dt = 0; dt < 4; ++dt)
#pragma unroll
                for (int g = 0; g < 4; ++g) { const float* pp = s0 + (size_t)(32 * dt + 8 * g) * 256;
                    S[dt][4 * g] = pp[0]; S[dt][4 * g + 1] = pp[256]; S[dt][4 * g + 2] = pp[512]; S[dt][4 * g + 3] = pp[768];
                    asm volatile("" ::: "memory"); }
        }
        f32x4 gn[4];
#pragma unroll
        for (int g = 0; g < 4; ++g) gn[g] = *(const f32x4*)(gnorm + 32 * w + 8 * g + 4 * hh);
        bf16x8 vf[4];
        {
            const bf16* vt = VT + ((size_t)(chunk0 * 4 + h) * 256 + 32 * w) * 64;
#pragma unroll
            for (int js = 0; js < 4; ++js) vf[js] = *(const bf16x8*)(vt + r * 64 + 16 * js + 8 * hh);
        }
        asm volatile("s_waitcnt vmcnt(0)" ::: "memory");
        __syncthreads();
        for (int c = 0; c < nchunk; ++c) {
            const int ch = chunk0 + c; const int row0 = smp ? MP + 8 * b : b * SEQ + 64 * c;
            LAS unsigned char* cur = lds + (c & 1) * REC_SLOT;
            u32x2 rg[2][4];
            if (c + 1 < nchunk) rec_stage(QIMG, KDIMG, PBE, ch + 1, h, lds + ((c + 1) & 1) * REC_SLOT, tid, lane, wave);
#pragma unroll
            for (int it = 0; it < 2; ++it)
#pragma unroll
                for (int g = 0; g < 4; ++g) { const int tok = 32 * it + r; const size_t row = (size_t)row0 + (tok < T ? tok : 0);
                    rg[it][g] = *(const u32x2*)(qkvr + row * NGLA + 2048 + h * 256 + 32 * w + 8 * g + 4 * hh); }
            f32x16 O[2];
#pragma unroll
            for (int i = 0; i < 16; ++i) { O[0][i] = 0.f; O[1][i] = 0.f; }
#pragma unroll
            for (int s = 0; s < 8; ++s) {
                const int po = ((2 * s + hh) ^ (r & 15)) << 4;
                const bf16x8 ps = (s & 1) ? pack8<1>(S[s >> 1]) : pack8<0>(S[s >> 1]);
                O[0] = MFMA32(ps, *(const LAS bf16x8*)(cur + r * 256 + po), O[0]);
                O[1] = MFMA32(ps, *(const LAS bf16x8*)(cur + (32 + r) * 256 + po), O[1]);
            }
            {
                const LAS unsigned char* pb = cur + 32768 + lane * 16;
                O[0] = MFMA32(vf[0], *(const LAS bf16x8*)(pb + 0 * 1024), O[0]); O[0] = MFMA32(vf[1], *(const LAS bf16x8*)(pb + 1 * 1024), O[0]);
                O[1] = MFMA32(vf[0], *(const LAS bf16x8*)(pb + 2 * 1024), O[1]); O[1] = MFMA32(vf[1], *(const LAS bf16x8*)(pb + 3 * 1024), O[1]);
                O[1] = MFMA32(vf[2], *(const LAS bf16x8*)(pb + 4 * 1024), O[1]); O[1] = MFMA32(vf[3], *(const LAS bf16x8*)(pb + 5 * 1024), O[1]);
            }
            LAS float* sb = ssqbuf + (c & 1) * 512;
#pragma unroll
            for (int it = 0; it < 2; ++it) { float ss = 0.f;
#pragma unroll
                for (int i = 0; i < 16; ++i) ss += O[it][i] * O[it][i];
                ss += __shfl_xor(ss, 32);
                if (hh == 0) sb[w * 64 + 32 * it + r] = ss; }
#pragma unroll
            for (int dt = 0; dt < 4; ++dt) {
#pragma unroll
                for (int g = 0; g < 4; ++g) { const f32x4 el = *(const LAS f32x4*)(cur + 32768 + 6144 + (32 * dt + 8 * g + 4 * hh) * 4);
                    S[dt][4 * g] *= el[0]; S[dt][4 * g + 1] *= el[1]; S[dt][4 * g + 2] *= el[2]; S[dt][4 * g + 3] *= el[3]; }
#pragma unroll
                for (int js = 0; js < 4; ++js) { const bf16x8 kd = *(const LAS bf16x8*)(cur + 16384 + (32 * dt + r) * 128 + (((2 * js + hh) ^ ((r >> 1) & 7)) << 4)); S[dt] = MFMA32(kd, vf[js], S[dt]); }
            }
            if (c + 1 < nchunk) {
                const bf16* vt = VT + ((size_t)((ch + 1) * 4 + h) * 256 + 32 * w) * 64;
#pragma unroll
                for (int js = 0; js < 4; ++js) vf[js] = *(const bf16x8*)(vt + r * 64 + 16 * js + 8 * hh);
            }
            __syncthreads();
#pragma unroll
            for (int it = 0; it < 2; ++it) {
                float tot = 0.f;
#pragma unroll
                for (int ww = 0; ww < 8; ++ww) tot += sb[ww * 64 + 32 * it + r];
                const float rstd = rsqrtf(tot * (1.f / 256.f) + EPS);
                const int tok = 32 * it + r;
                if (tok < T) {
                    const size_t row = (size_t)row0 + tok;
#pragma unroll
                    for (int g = 0; g < 4; ++g) {
                        const int vb = 32 * w + 8 * g + 4 * hh;
                        const u32x2 rr = rg[it][g];
                        const float r0 = __uint_as_float(rr.x << 16), r1 = __uint_as_float(rr.x & 0xffff0000u), r2 = __uint_as_float(rr.y << 16), r3 = __uint_as_float(rr.y & 0xffff0000u);
                        u32x2 o; o.x = cvtpk(O[it][4 * g] * rstd * gn[g][0] * silu(r0), O[it][4 * g + 1] * rstd * gn[g][1] * silu(r1));
                        o.y = cvtpk(O[it][4 * g + 2] * rstd * gn[g][2] * silu(r2), O[it][4 * g + 3] * rstd * gn[g][3] * silu(r3));
                        *(u32x2*)(AG + row * D + h * 256 + vb) = o;
                    }
                }
            }
            asm volatile("s_waitcnt vmcnt(0)" ::: "memory");
            __syncthreads();
        }
        float* so = a.out + (smp ? O_SS : O_SP) + ((size_t)(b * 4 + h) * 128 + 4 * hh) * 256 + 32 * w + r;
#pragma unroll
        for (int dt = 0; dt < 4; ++dt)
#pragma unroll
            for (int g = 0; g < 4; ++g) { float* pp = so + (size_t)(32 * dt + 8 * g) * 256;
                pp[0] = S[dt][4 * g]; pp[256] = S[dt][4 * g + 1]; pp[512] = S[dt][4 * g + 2]; pp[768] = S[dt][4 * g + 3]; }
        __syncthreads();
    }
}

DI void kv_post_item(const Args& a, int item, int tid) {
    unsigned char* ws = a.ws;
    const float* kvraw = (const float*)(ws + WS_U2);
    bf16* Kb = (bf16*)(ws + WS_U3); bf16* VTd = Kb + (size_t)MP * 256;
    const float* rope = (const float*)(ws + W_ROPE);
    const int t = tid >> 3, sub = tid & 7, hd = sub & 3, isV = sub >> 2;
    const int row = 64 * item + t; const bool prompt = row < MP;
    const float* src = kvraw + (size_t)row * 512 + isV * 256 + hd * 64;
    float v[64];
#pragma unroll
    for (int i = 0; i < 16; ++i) { const f32x4 x = *(const f32x4*)(src + 4 * i); v[4 * i] = x[0]; v[4 * i + 1] = x[1]; v[4 * i + 2] = x[2]; v[4 * i + 3] = x[3]; }
    if (!isV) {
        float ss = 0.f;
#pragma unroll
        for (int i = 0; i < 64; ++i) ss += v[i] * v[i];
        const float rk = rsqrtf(ss * (1.f / 64.f) + EPS);
        const int pidx = prompt ? (row & 2047) : 2048 + ((row - MP) & 7);
        const float* kn = a.in[15];
#pragma unroll
        for (int i = 0; i < 32; ++i) {
            const float x1 = v[i] * rk * kn[i], x2 = v[i + 32] * rk * kn[i + 32];
            const float cs = rope[(pidx * 32 + i) * 2], sn = rope[(pidx * 32 + i) * 2 + 1];
            v[i] = x1 * cs - x2 * sn; v[i + 32] = x1 * sn + x2 * cs;
        }
        float* ok = prompt ? a.out + O_KP + (size_t)row * 256 + hd * 64 : a.out + O_KS + (size_t)(row - MP) * 256 + hd * 64;
#pragma unroll
        for (int i = 0; i < 16; ++i) { f32x4 x; x[0] = v[4 * i]; x[1] = v[4 * i + 1]; x[2] = v[4 * i + 2]; x[3] = v[4 * i + 3]; *(f32x4*)(ok + 4 * i) = x; }
        if (prompt) {
            bf16* kb = Kb + (size_t)row * 256 + hd * 64;
#pragma unroll
            for (int i = 0; i < 8; ++i) { u32x4 o; o.x = cvtpk(v[8 * i], v[8 * i + 1]); o.y = cvtpk(v[8 * i + 2], v[8 * i + 3]); o.z = cvtpk(v[8 * i + 4], v[8 * i + 5]); o.w = cvtpk(v[8 * i + 6], v[8 * i + 7]); *(u32x4*)(kb + 8 * i) = o; }
        }
    } else {
        float* ov = prompt ? a.out + O_VP + (size_t)row * 256 + hd * 64 : a.out + O_VS + (size_t)(row - MP) * 256 + hd * 64;
#pragma unroll
        for (int i = 0; i < 16; ++i) { f32x4 x; x[0] = v[4 * i]; x[1] = v[4 * i + 1]; x[2] = v[4 * i + 2]; x[3] = v[4 * i + 3]; *(f32x4*)(ov + 4 * i) = x; }
        if (prompt) {
            const int b = row >> 11, tk = row & 2047;
#pragma unroll
            for (int gi = 0; gi < 3; ++gi) {
                const int dl = gi == 0 ? 1 : (gi == 1 ? 4 : 16), L = SEQ / dl;
                const int pos = (tk % dl) * L + swz(tk / dl);
                bf16* vt = VTd + (size_t)gi * 8 * 4 * 64 * SEQ + ((size_t)(b * 4 + hd) * 64) * SEQ + pos;
#pragma unroll
                for (int i = 0; i < 64; ++i) vt[(size_t)i * SEQ] = f2bf(v[i]);
            }
        }
    }
}

DI void attn_tile(const Args& a, int b, int j, int g, int res, int a0, int lane) {
    unsigned char* ws = a.ws;
    const bf16* qraw = (const bf16*)(ws + WS_U1);
    const bf16* Kb = (const bf16*)(ws + WS_U3); const bf16* VTd = Kb + (size_t)MP * 256;
    float* OG = (float*)(ws + WS_U2); float* LSE = (float*)(ws + WS_LSE);
    const float* rope = (const float*)(ws + W_ROPE);
    const float* qn = a.in[17];
    const int r = lane & 31, hh = lane >> 5;
    const int dl = g == 0 ? 1 : (g == 1 ? 4 : 16), L = SEQ / dl;
    const int tq = dl * (a0 + r) + res; const size_t row = (size_t)b * SEQ + tq;
    const int qh = g * 4 + j;
    bf16x8 qf[4];
    {
        float x[4][8];
#pragma unroll
        for (int s = 0; s < 4; ++s) { const u32x4 v = *(const u32x4*)(qraw + row * 768 + qh * 64 + 16 * s + 8 * hh);
            x[s][0] = __uint_as_float(v.x << 16); x[s][1] = __uint_as_float(v.x & 0xffff0000u); x[s][2] = __uint_as_float(v.y << 16); x[s][3] = __uint_as_float(v.y & 0xffff0000u);
            x[s][4] = __uint_as_float(v.z << 16); x[s][5] = __uint_as_float(v.z & 0xffff0000u); x[s][6] = __uint_as_float(v.w << 16); x[s][7] = __uint_as_float(v.w & 0xffff0000u); }
        float ss = 0.f;
#pragma unroll
        for (int s = 0; s < 4; ++s)
#pragma unroll
            for (int e = 0; e < 8; ++e) ss += x[s][e] * x[s][e];
        ss += __shfl_xor(ss, 32);
        const float rq = rsqrtf(ss * (1.f / 64.f) + EPS) ;
#pragma unroll
        for (int s = 0; s < 2; ++s)
#pragma unroll
            for (int e = 0; e < 8; ++e) {
                const int i = 16 * s + 8 * hh + e;
                const float x1 = x[s][e] * rq * qn[i], x2 = x[s + 2][e] * rq * qn[i + 32];
                const float cs = rope[(tq * 32 + i) * 2], sn = rope[(tq * 32 + i) * 2 + 1];
                x[s][e] = (x1 * cs - x2 * sn) * 0.125f; x[s + 2][e] = (x1 * sn + x2 * cs) * 0.125f;
            }
#pragma unroll
        for (int s = 0; s < 4; ++s) { u32x4 p; p.x = cvtpk(x[s][0], x[s][1]); p.y = cvtpk(x[s][2], x[s][3]); p.z = cvtpk(x[s][4], x[s][5]); p.w = cvtpk(x[s][6], x[s][7]); qf[s] = __builtin_bit_cast(bf16x8, p); }
    }
    f32x16 ST[5];
#pragma unroll
    for (int kt = 0; kt < 5; ++kt) {
        int ks = a0 - 128 + 32 * kt + r; ks = ks < 0 ? 0 : ks;
        const bf16* kp = Kb + ((size_t)b * SEQ + dl * ks + res) * 256 + j * 64 + 8 * hh;
#pragma unroll
        for (int i = 0; i < 16; ++i) ST[kt][i] = 0.f;
#pragma unroll
        for (int s = 0; s < 4; ++s) { const bf16x8 kf = *(const bf16x8*)(kp + 16 * s); ST[kt] = MFMA32(kf, qf[s], ST[kt]); }
        asm volatile("" ::: "memory");
    }
    float mx = -INFINITY;
#pragma unroll
    for (int kt = 0; kt < 5; ++kt)
#pragma unroll
        for (int i = 0; i < 16; ++i) {
            const int krel = 32 * kt - 128 + crow(i, hh);
            const bool valid = (krel <= r) && (krel + 128 >= r) && (a0 + krel >= 0);
            ST[kt][i] = valid ? ST[kt][i] : -INFINITY;
            mx = fmaxf(mx, ST[kt][i]);
        }
    mx = fmaxf(mx, __shfl_xor(mx, 32));
    float den = 0.f;
#pragma unroll
    for (int kt = 0; kt < 5; ++kt)
#pragma unroll
        for (int i = 0; i < 16; ++i) { const float p = __expf(ST[kt][i] - mx); ST[kt][i] = p; den += p; }
    den += __shfl_xor(den, 32);
    f32x16 OT[2];
#pragma unroll
    for (int i = 0; i < 16; ++i) { OT[0][i] = 0.f; OT[1][i] = 0.f; }
    const bf16* vbase = VTd + (size_t)g * 8 * 4 * 64 * SEQ + ((size_t)(b * 4 + j) * 64 + r) * SEQ + res * L + 8 * hh;
#pragma unroll
    for (int kt = 0; kt < 5; ++kt) {
        const bf16x8 p0 = pack8<0>(ST[kt]), p1 = pack8<1>(ST[kt]);
        int s0 = a0 - 128 + 32 * kt; const int s0a = s0 < 0 ? 0 : s0; const int s0b = s0 + 16 < 0 ? 0 : s0 + 16;
        OT[0] = MFMA32(*(const bf16x8*)(vbase + s0a), p0, OT[0]);
        OT[1] = MFMA32(*(const bf16x8*)(vbase + (size_t)32 * SEQ + s0a), p0, OT[1]);
        OT[0] = MFMA32(*(const bf16x8*)(vbase + s0b), p1, OT[0]);
        OT[1] = MFMA32(*(const bf16x8*)(vbase + (size_t)32 * SEQ + s0b), p1, OT[1]);
        asm volatile("" ::: "memory");
    }
    const float inv = 1.f / den;
#pragma unroll
    for (int mt = 0; mt < 2; ++mt)
#pragma unroll
        for (int q = 0; q < 4; ++q) { f32x4 o; o[0] = OT[mt][4 * q] * inv; o[1] = OT[mt][4 * q + 1] * inv; o[2] = OT[mt][4 * q + 2] * inv; o[3] = OT[mt][4 * q + 3] * inv;
            *(f32x4*)(OG + row * 768 + qh * 64 + 32 * mt + 8 * q + 4 * hh) = o; }
    if (hh == 0) LSE[row * 12 + qh] = mx + __logf(den);
}

DI void attn_sample_unit(const Args& a, LAS unsigned char* lds, int unit, int lane, int wave) {
    unsigned char* ws = a.ws;
    const bf16* qraw = (const bf16*)(ws + WS_U1);
    bf16* AA = (bf16*)(ws + WS_U1 + 32 * MiB);
    const float* rope = (const float*)(ws + W_ROPE);
    const float* qn = a.in[17];
    LAS float* qs = (LAS float*)(lds + 8192 + wave * 1024);
    LAS float* ps = qs + 64;
    const int b = unit >> 5, j = (unit >> 3) & 3, t = unit & 7;
    const size_t row = (size_t)MP + 8 * b + t;
    const float* cK = a.in[3]; const float* cV = a.in[4];
    const float* nK = a.out + O_KS; const float* nV = a.out + O_VS;
    float og0 = 0.f, og1 = 0.f, og2 = 0.f, l0 = 0.f, l1 = 0.f, l2 = 0.f;
#pragma unroll 1
    for (int g = 0; g < 3; ++g) {
        const int dl = g == 0 ? 1 : (g == 1 ? 4 : 16);
        const int qh = g * 4 + j;
        const float x = bf2f(qraw[row * 768 + qh * 64 + lane]);
        const float ss = wave_sum(x * x);
        const float xn = x * rsqrtf(ss * (1.f / 64.f) + EPS) * qn[lane];
        const float xp = __shfl_xor(xn, 32);
        const int i = lane & 31;
        const float cs = rope[((2048 + t) * 32 + i) * 2], sn = rope[((2048 + t) * 32 + i) * 2 + 1];
        const float y = lane < 32 ? xn * cs - xp * sn : xp * sn + xn * cs;
        qs[lane] = y * 0.125f;
        asm volatile("s_waitcnt lgkmcnt(0)" ::: "memory");
        float mx = -INFINITY;
#pragma unroll 1
        for (int rr = 0; rr < 3; ++rr) {
            const int jj = 64 * rr + lane;
            float dot = -INFINITY;
            if (jj <= 128) {
                const int srow = 2048 + t - dl * jj;
                const float* kp = srow >= 2048 ? nK + ((size_t)(8 * b + srow - 2048) * 4 + j) * 64 : cK + (((size_t)b * 2048 + srow) * 4 + j) * 64;
                float acc = 0.f;
#pragma unroll
                for (int q = 0; q < 16; ++q) { const f32x4 kv = *(const f32x4*)(kp + 4 * q); const f32x4 qv = *(const LAS f32x4*)(qs + 4 * q); acc += kv[0] * qv[0] + kv[1] * qv[1] + kv[2] * qv[2] + kv[3] * qv[3]; }
                dot = acc;
            }
            ps[jj] = dot; mx = fmaxf(mx, dot);
            asm volatile("" ::: "memory");
        }
        mx = wave_max(mx);
        float ds = 0.f;
#pragma unroll 1
        for (int rr = 0; rr < 3; ++rr) { const int jj = 64 * rr + lane; const float pv = __expf(ps[jj] - mx); ps[jj] = pv; ds += pv; }
        const float den = wave_sum(ds);
        asm volatile("s_waitcnt lgkmcnt(0)" ::: "memory");
        float o = 0.f;
#pragma unroll 16
        for (int jj = 0; jj <= 128; ++jj) {
            const float pj = ps[jj];
            const int srow = 2048 + t - dl * jj;
            const float* vp = srow >= 2048 ? nV + ((size_t)(8 * b + srow - 2048) * 4 + j) * 64 : cV + (((size_t)b * 2048 + srow) * 4 + j) * 64;
            o += pj * vp[lane];
        }
        { const float ov = o / den, lv = mx + __logf(den); if (g == 0) { og0 = ov; l0 = lv; } else if (g == 1) { og1 = ov; l1 = lv; } else { og2 = ov; l2 = lv; } }
        asm volatile("s_waitcnt lgkmcnt(0)" ::: "memory");
    }
    const float lm = fmaxf(fmaxf(l0, l1), l2);
    const float e0 = __expf(l0 - lm), e1 = __expf(l1 - lm), e2 = __expf(l2 - lm), is = 1.f / (e0 + e1 + e2);
    AA[row * 768 + (0 + j) * 64 + lane] = f2bf(og0 * e0 * is);
    AA[row * 768 + (4 + j) * 64 + lane] = f2bf(og1 * e1 * is);
    AA[row * 768 + (8 + j) * 64 + lane] = f2bf(og2 * e2 * is);
}

DI void attn_phase(const Args& a, LAS unsigned char* lds, int tid, int lane, int wave) {
    unsigned char* ws = a.ws;
    const int G = gridDim.x, GP = G > 1 ? G / 2 : 1;
    if ((int)blockIdx.x < GP) {
        const float* OG = (const float*)(ws + WS_U2); const float* LSE = (const float*)(ws + WS_LSE);
        bf16* AA = (bf16*)(ws + WS_U1 + 32 * MiB);
        for (int u = blockIdx.x; u < 128; u += GP) {
            const int b = u >> 4, j = (u >> 2) & 3, sp = u & 3, T0 = 512 * sp;
            for (int jb = wave; jb < 48; jb += 8) {
                const int g = jb >> 4, q = jb & 15;
                const int dl = g == 0 ? 1 : (g == 1 ? 4 : 16), tpr = 16 / dl;
                const int res = q / tpr, a0 = T0 / dl + 32 * (q % tpr);
                attn_tile(a, b, j, g, res, a0, lane);
            }
            __builtin_amdgcn_fence(__ATOMIC_RELEASE, "agent");
            __syncthreads();
            __builtin_amdgcn_fence(__ATOMIC_ACQUIRE, "agent");
            {
                const size_t row = (size_t)b * SEQ + T0 + tid;
                const float l0 = LSE[row * 12 + j], l1 = LSE[row * 12 + 4 + j], l2 = LSE[row * 12 + 8 + j];
                const float lm = fmaxf(fmaxf(l0, l1), l2);
                const float e0 = __expf(l0 - lm), e1 = __expf(l1 - lm), e2 = __expf(l2 - lm), is = 1.f / (e0 + e1 + e2);
#pragma unroll
                for (int g = 0; g < 3; ++g) {
                    const float wg = (g == 0 ? e0 : (g == 1 ? e1 : e2)) * is;
                    const float* src = OG + row * 768 + (g * 4 + j) * 64; bf16* dst = AA + row * 768 + (g * 4 + j) * 64;
#pragma unroll
                    for (int i = 0; i < 8; ++i) { const f32x4 x0 = *(const f32x4*)(src + 8 * i), x1 = *(const f32x4*)(src + 8 * i + 4);
                        u32x4 o; o.x = cvtpk(x0[0] * wg, x0[1] * wg); o.y = cvtpk(x0[2] * wg, x0[3] * wg); o.z = cvtpk(x1[0] * wg, x1[1] * wg); o.w = cvtpk(x1[2] * wg, x1[3] * wg);
                        *(u32x4*)(dst + 8 * i) = o; }
                }
            }
            __syncthreads();
        }
    } else {
        const int nb = G - GP;
        for (int u = ((int)blockIdx.x - GP) * 8 + wave; u < 1024; u += nb * 8) attn_sample_unit(a, lds, u, lane, wave);
    }
}

__global__ void __launch_bounds__(512, 2) mk_fwd(Args a) {
    extern __shared__ __attribute__((aligned(16))) unsigned char lds_raw[];
    LAS unsigned char* lds = (LAS unsigned char*)lds_raw;
    cg::grid_group grid = cg::this_grid();
    const int tid = threadIdx.x, lane = tid & 63, wave = __builtin_amdgcn_readfirstlane(tid >> 6);
    unsigned char* ws = a.ws;
    const int lo = a.ph_lo, hi = a.ph_hi, G = gridDim.x, bx = blockIdx.x;
    float* ssq = (float*)(ws + WS_SSQ);
    bf16* XB = (bf16*)(ws + WS_XB);
    bf16* ACT = (bf16*)(ws + WS_U1);
#define IN(k) (lo <= (k) && (k) < hi)
#define SEAM(k) do { if (IN(k) && IN((k) + 1)) grid.sync(); } while (0)
#define GEMM(EpiT, E, Aptr, Bptr, N_, K_, cidx) do { pg8::Gemm g_{(const pg8::bf16_t*)(Aptr), (const pg8::bf16_t*)(Bptr), M, (N_), (K_)}; pg8::StaticOrder S_; S_.init(M, (N_), G, (cidx)); \
        pg8::gemm_phase<EpiT, pg8::StaticOrder, true, true>(lds, g_, S_, E); } while (0)
#define FFN_IN(mi, slot) do { EpiSwiGLU E_{ACT, ssq + (slot) * M}; GEMM(EpiSwiGLU, E_, XB, (bf16*)(ws + W_FI) + (size_t)(mi) * 2 * FF * D, 2 * FF, D, bx); } while (0)
#define FFN_OUT(mi, slot, last) do { EpiResid E_{a.out, (last) ? nullptr : XB, (last) ? nullptr : ssq + (slot) * M, 0.5f}; GEMM(EpiResid, E_, ACT, (bf16*)(ws + W_FO) + (size_t)(mi) * D * FF, D, FF, bx); } while (0)

    if (IN(0)) { p0_prologue(a, lds, tid, lane, wave); __syncthreads(); } SEAM(0);
    if (IN(1)) { FFN_IN(0, 0); } SEAM(1);
    if (IN(2)) { FFN_OUT(0, 1, false); } SEAM(2);
    if (IN(3)) { EpiScale E_{(bf16*)(ws + WS_U1), nullptr, NGLA, ssq + 1 * M}; GEMM(EpiScale, E_, XB, ws + W_GI, NGLA, D, bx); } SEAM(3);
    if (IN(4)) { gla_prep(a, lds, tid, lane, wave); } SEAM(4);
    if (IN(5)) { gla_rec(a, lds, tid, lane, wave); } SEAM(5);
    if (IN(6)) { EpiResid E_{a.out, XB, ssq + 2 * M, 1.0f}; GEMM(EpiResid, E_, ws + WS_U3, ws + W_GO, D, D, bx); } SEAM(6);
    if (IN(7)) { FFN_IN(1, 2); } SEAM(7);
    if (IN(8)) { FFN_OUT(1, 3, false); } SEAM(8);
    if (IN(9)) {
        { EpiScale E_{nullptr, (float*)(ws + WS_U2), 512, ssq + 3 * M}; GEMM(EpiScale, E_, XB, ws + W_KV, 512, D, bx); }
        { EpiSwiGLU E_{ACT, ssq + 3 * M}; GEMM(EpiSwiGLU, E_, XB, (bf16*)(ws + W_FI) + (size_t)2 * 2 * FF * D, 2 * FF, D, (G == 256) ? ((bx + 120) & 255) : bx); }
    } SEAM(9);
    if (IN(10)) {
        FFN_OUT(2, 4, false);
        if (G > 8) { if (bx >= 4) for (int it = bx - 4; it < M / 64; it += G - 4) kv_post_item(a, it, tid); }
        else for (int it = bx; it < M / 64; it += G) kv_post_item(a, it, tid);
    } SEAM(10);
    if (IN(11)) { EpiScale E_{(bf16*)(ws + WS_U1), nullptr, 768, ssq + 4 * M}; GEMM(EpiScale, E_, XB, ws + W_Q, 768, D, bx); } SEAM(11);
    if (IN(12)) { attn_phase(a, lds, tid, lane, wave); } SEAM(12);
    if (IN(13)) { EpiResid E_{a.out, XB, ssq + 5 * M, 1.0f}; GEMM(EpiResid, E_, ws + WS_U1 + 32 * MiB, ws + W_AO, D, 768, bx); } SEAM(13);
    if (IN(14)) { FFN_IN(3, 5); } SEAM(14);
    if (IN(15)) { FFN_OUT(3, 0, true); }
}

extern "C" void kernel_launch(void* const* d_in, const int* in_sizes, int n_in, void* d_out, int out_size, void* d_ws, size_t ws_size, hipStream_t stream) {
    static int grid = 0;
    if (grid == 0) {
        if (n_in != 19 || ws_size < WS_END) { fprintf(stderr, "kernel_launch: expected 19 inputs and >= %zu bytes of workspace (got %d, %zu)\n", (size_t)WS_END, n_in, ws_size); grid = -1; return; }
        int dev = 0, cus = 0, per_cu = 0;
        (void)hipGetDevice(&dev); (void)hipDeviceGetAttribute(&cus, hipDeviceAttributeMultiprocessorCount, dev);
        if (hipFuncSetAttribute((const void*)mk_fwd, hipFuncAttributeMaxDynamicSharedMemorySize, LDS_BYTES) != hipSuccess) { fprintf(stderr, "kernel_launch: hipFuncSetAttribute failed\n"); grid = -1; return; }
        if (hipOccupancyMaxActiveBlocksPerMultiprocessor(&per_cu, (const void*)mk_fwd, 512, LDS_BYTES) != hipSuccess || per_cu < 1) { fprintf(stderr, "kernel_launch: occupancy query failed (%d)\n", per_cu); per_cu = 1; }
        (void)hipGetLastError();
        grid = cus * (per_cu > 1 ? 1 : per_cu);
        if (grid <= 0) grid = 256;
    }
    if (grid < 0) return;
    Args a{};
    for (int i = 0; i < 19; ++i) a.in[i] = (const float*)d_in[i];
    a.out = (float*)d_out; a.ws = (unsigned char*)d_ws;
#if MK_PER_PHASE
    for (int p = 0; p < NPHASE; ++p) { a.ph_lo = p; a.ph_hi = p + 1; hipLaunchKernelGGL(mk_fwd, dim3(grid), dim3(512), LDS_BYTES, stream, a); }
#else
    a.ph_lo = 0; a.ph_hi = NPHASE;
    void* args[] = {&a};
    hipError_t e = hipLaunchCooperativeKernel((const void*)mk_fwd, dim3(grid), dim3(512), args, LDS_BYTES, stream);
    if (e != hipSuccess) fprintf(stderr, "kernel_launch: cooperative launch failed: %s (grid %d)\n", hipGetErrorString(e), grid);
#endif
}
```

```cpp
#include <hip/hip_runtime.h>
#include <hip/hip_cooperative_groups.h>
#include <cstdio>
#include <cstdint>
namespace cg = cooperative_groups;
namespace pg8 {
#define PG8_LAS __attribute__((address_space(3)))
typedef unsigned short bf16_t;
typedef short bf16x8 __attribute__((ext_vector_type(8)));
typedef float f32x4 __attribute__((ext_vector_type(4)));
typedef unsigned u32x4 __attribute__((ext_vector_type(4)));
constexpr int BM = 256, BK = 64, HALF = 128, HTB = HALF * BK * 2  , STAGE_BYTES = 8 * HTB, NXCD = 8, WGM = 8;

__host__ __device__ __forceinline__ int lds_byte(int r, int c) { const int st = (r >> 4) * 2 + (c >> 5), rr = r & 15, cc = c & 31, ob = rr * 64 + cc * 2; return st * 1024 + (ob ^ (((ob >> 9) & 1) << 5)); }
__host__ __device__ __forceinline__ void stage_rc(int b, int& R, int& C) { const int st = b / 1024, sb = b % 1024, swz = sb ^ (((sb >> 9) & 1) << 5); R = (st >> 1) * 16 + swz / 64; C = (st & 1) * 32 + (swz % 64) / 2; }
__host__ __device__ __forceinline__ int perm32(int rho) { const int n = rho >> 4, i = rho & 15; return 8 * (i >> 2) + 4 * n + (i & 3); }

struct Unit { int pm, pn; };
struct Gemm { const bf16_t* A; const bf16_t* Bt; int M, N, K; };

struct StaticOrder {
    int nM, nN, nwg, G, c;
    __host__ __device__ void init(int M, int N, int G_, int c_) { nM = M / BM; nN = N / BM; nwg = nM * nN; G = G_; c = c_; }
    __host__ __device__ bool next(int i, Unit& u) const {
        const long L = (long)i * G + c; if (L >= nwg) return false;
        int wgid = (int)L; { const int q = nwg / NXCD, r = nwg % NXCD, xcd = wgid % NXCD, off = wgid / NXCD; wgid = (xcd < r ? xcd * (q + 1) : r * (q + 1) + (xcd - r) * q) + off; }
        const int nig = WGM * nN, gid = wgid / nig, fm = gid * WGM, gsz = (nM - fm) < WGM ? (nM - fm) : WGM;
        u.pm = fm + ((wgid % nig) % gsz); u.pn = (wgid % nig) / gsz; return true;
    }
    __device__ __forceinline__ void a_ready(const Unit&) const {}
    __device__ __forceinline__ void done(const Unit&) const {}
};

__device__ __forceinline__ unsigned cvt_pk_bf16(float lo, float hi) { unsigned r; asm volatile("v_cvt_pk_bf16_f32 %0, %1, %2" : "=v"(r) : "v"(lo), "v"(hi)); return r; }
typedef float f32x2 __attribute__((ext_vector_type(2)));
__device__ __forceinline__ f32x2 gelu_pk(f32x2 v) {
    const f32x2 av = __builtin_elementwise_abs(v), d = av * 0.2316418882f + 1.0f;
    f32x2 t; t.x = __builtin_amdgcn_rcpf(d.x); t.y = __builtin_amdgcn_rcpf(d.y);
    f32x2 q = t * 0.5307027145f + (-0.7265760135f); q = q * t + 0.7107068705f; q = q * t + (-0.142248368f); q = q * t + 0.127414796f; q = q * t;
    const f32x2 s = (v * v) * (-0.72134752044f);
    f32x2 e; e.x = __builtin_amdgcn_exp2f(s.x); e.y = __builtin_amdgcn_exp2f(s.y);
    const f32x2 m = v * (q * e), r = v - m;
    f32x2 o; o.x = v.x < 0.f ? m.x : r.x; o.y = v.y < 0.f ? m.y : r.y; return o;
}

template <int ACT  > struct EpiBf16 {
    static constexpr bool PERM = true, AFTER_DRAIN = false; static_assert(ACT == 0 || ACT == 1, "EpiBf16: ACT is 0 (none) or 1 (gelu_pk)");
    bf16_t* O; int ldc; const float* bias; int split_cols; size_t split_stride; float scale0;
    __device__ __forceinline__ void operator()(const f32x4 (&acc)[2][2][4][2], const Unit& u, int wr, int wc, int fr, int fq) const {
        const int row0 = u.pm * BM + wr * 64 + fr; int colt = u.pn * BM; bf16_t* base = O;
        float sc = 1.f; if (split_cols) { const int t = colt / split_cols; base += (size_t)t * split_stride; colt -= t * split_cols; if (t == 0) sc = scale0; }
        const int col0 = colt + wc * 32 + 8 * fq, bcol0 = u.pn * BM + wc * 32 + 8 * fq;
        f32x4 bv[2][2];
#pragma unroll
        for (int bj = 0; bj < 2; ++bj)
#pragma unroll
            for (int n = 0; n < 2; ++n) bv[bj][n] = bias ? *(const f32x4*)(bias + bcol0 + bj * HALF + 4 * n) : (f32x4){0.f, 0.f, 0.f, 0.f};
#pragma unroll
        for (int ai = 0; ai < 2; ++ai)
#pragma unroll
            for (int m = 0; m < 4; ++m) { bf16_t* rowp = base + (size_t)(row0 + ai * HALF + m * 16) * ldc + col0;
#pragma unroll
                for (int bj = 0; bj < 2; ++bj) { f32x4 v0 = acc[ai][bj][m][0] + bv[bj][0], v1 = acc[ai][bj][m][1] + bv[bj][1];
                    if (ACT == 1) { f32x2 a = gelu_pk((f32x2){v0[0], v0[1]}), b = gelu_pk((f32x2){v0[2], v0[3]}), c = gelu_pk((f32x2){v1[0], v1[1]}), d = gelu_pk((f32x2){v1[2], v1[3]});
                        v0 = (f32x4){a.x, a.y, b.x, b.y}; v1 = (f32x4){c.x, c.y, d.x, d.y}; }
                    v0 = v0 * sc; v1 = v1 * sc; u32x4 w; w.x = cvt_pk_bf16(v0[0], v0[1]); w.y = cvt_pk_bf16(v0[2], v0[3]); w.z = cvt_pk_bf16(v1[0], v1[1]); w.w = cvt_pk_bf16(v1[2], v1[3]);
                    *(u32x4*)(rowp + bj * HALF) = w; } }
    }
};

struct PanelStats {
    unsigned* xbuf;
    unsigned* cnt;
    unsigned* tmo;
    int ntn; float eps;
    unsigned code;
    __device__ __forceinline__ bool run(const f32x4 (&v)[2][2][4][2], const Unit& u, int wr, int wc, int fr, int fq, PG8_LAS unsigned char* lds, int wid, int lane) const {
        typedef float f32x2v __attribute__((ext_vector_type(2)));
        PG8_LAS f32x2v* P = (PG8_LAS f32x2v*)lds;
        PG8_LAS f32x2v* S = (PG8_LAS f32x2v*)(lds + 8192);
        PG8_LAS unsigned* flag = (PG8_LAS unsigned*)(lds + 8192 + 2048);
#pragma unroll
        for (int ai = 0; ai < 2; ++ai)
#pragma unroll
            for (int m = 0; m < 4; ++m) {
                float s = 0.f;
#pragma unroll
                for (int bj = 0; bj < 2; ++bj)
#pragma unroll
                    for (int n = 0; n < 2; ++n) { const f32x4 x = v[ai][bj][m][n]; s += (x[0] + x[1]) + (x[2] + x[3]); }
                s += __shfl_xor(s, 16); s += __shfl_xor(s, 32);
                const float mw = s * (1.0f / 64.0f); float q = 0.f;
#pragma unroll
                for (int bj = 0; bj < 2; ++bj)
#pragma unroll
                    for (int n = 0; n < 2; ++n) { const f32x4 d = v[ai][bj][m][n] - mw; q += (d[0] * d[0] + d[1] * d[1]) + (d[2] * d[2] + d[3] * d[3]); }
                q += __shfl_xor(q, 16); q += __shfl_xor(q, 32);
                if (fq == 0) P[(ai * HALF + wr * 64 + m * 16 + fr) * 4 + wc] = (f32x2v){mw, q};
            }
        asm volatile("s_waitcnt lgkmcnt(0)" ::: "memory"); __builtin_amdgcn_s_barrier(); asm volatile("" ::: "memory");
#if defined(BROKEN_EXCHANGE_NO_WAIT)
#warning BROKEN CONTROL BUILD: the row-statistics exchange does not wait; results are wrong by design
        if (blockIdx.x >= 64) { const long long t0_ = clock64(); while (clock64() - t0_ < 60000) __builtin_amdgcn_s_sleep(8); }
#endif
        const int row = wid * 32 + (lane & 31);
        if (lane < 32) {
            const f32x2v a = P[row * 4 + 0], b = P[row * 4 + 1], c = P[row * 4 + 2], d = P[row * 4 + 3];
            const float mt = (a.x + b.x + c.x + d.x) * 0.25f;
            const float da = a.x - mt, db = b.x - mt, dc = c.x - mt, dd = d.x - mt;
            const float m2 = (a.y + b.y) + (c.y + d.y) + 64.0f * ((da * da + db * db) + (dc * dc + dd * dd));
            unsigned long long* slot = (unsigned long long*)xbuf + ((size_t)(u.pm * BM + row) * 4 + u.pn);
            __hip_atomic_store(slot, ((unsigned long long)__float_as_uint(m2) << 32) | __float_as_uint(mt), __ATOMIC_RELAXED, __HIP_MEMORY_SCOPE_AGENT);
        }
        asm volatile("s_waitcnt vmcnt(0)" ::: "memory");
        if (lane == 0) __hip_atomic_fetch_add(cnt + 64 * u.pm, 1u, __ATOMIC_RELAXED, __HIP_MEMORY_SCOPE_AGENT);
        if (wid == 0) {
            bool dead = false; const unsigned long long t0 = __builtin_amdgcn_s_memrealtime(); const unsigned want = 8u * (unsigned)ntn;
            for (;;) {
#if defined(BROKEN_EXCHANGE_NO_WAIT)
                break;
#endif
                if ((unsigned)__builtin_amdgcn_readfirstlane(__hip_atomic_load(cnt + 64 * u.pm, __ATOMIC_RELAXED, __HIP_MEMORY_SCOPE_AGENT)) >= want) break;
                if (__builtin_amdgcn_s_memrealtime() - t0 > 2000000ull) {
                    if (lane == 0) { unsigned expect = 0u; __hip_atomic_compare_exchange_strong(tmo + 1, &expect, code | (unsigned)(u.pm & 0xff), __ATOMIC_RELAXED, __ATOMIC_RELAXED, __HIP_MEMORY_SCOPE_AGENT);
                                     __hip_atomic_store(tmo, 1u, __ATOMIC_RELAXED, __HIP_MEMORY_SCOPE_AGENT); }
                    dead = true; break; }
                __builtin_amdgcn_s_sleep(2);
            }
            __builtin_amdgcn_fence(__ATOMIC_ACQUIRE, "agent");
            if (lane == 0) flag[0] = dead ? 1u : 0u;
        }
        asm volatile("s_waitcnt vmcnt(0) lgkmcnt(0)" ::: "memory"); __builtin_amdgcn_s_barrier(); asm volatile("" ::: "memory");
        const bool bad = flag[0] != 0u;
        if (lane < 32) {
            const unsigned long long* slot = (const unsigned long long*)xbuf + (size_t)(u.pm * BM + row) * 4; float mt[4], m2[4]; float ms = 0.f;
#pragma unroll
            for (int t = 0; t < 4; ++t) { if (t < ntn) { const unsigned long long w = __hip_atomic_load(slot + t, __ATOMIC_RELAXED, __HIP_MEMORY_SCOPE_AGENT); mt[t] = __uint_as_float((unsigned)w); m2[t] = __uint_as_float((unsigned)(w >> 32)); } else { mt[t] = 0.f; m2[t] = 0.f; } ms += mt[t]; }
            const float mean = ms / (float)ntn; float q = 0.f;
#pragma unroll
            for (int t = 0; t < 4; ++t) if (t < ntn) { const float dm = mt[t] - mean; q += m2[t] + 256.0f * dm * dm; }
            S[row] = (f32x2v){mean, 1.0f / sqrtf(q / (256.0f * (float)ntn) + eps)};
        }
        asm volatile("s_waitcnt lgkmcnt(0)" ::: "memory"); __builtin_amdgcn_s_barrier(); asm volatile("" ::: "memory");
        return bad;
    }
};
struct EpiLnRes {
    static constexpr bool PERM = false, AFTER_DRAIN = true;
    const float* base; float* out; int ldc; const float* bias; PanelStats st; unsigned poison;
    __device__ __forceinline__ void fused(f32x4 (&acc)[2][2][4][2], const Unit& u, int wr, int wc, int fr, int fq, PG8_LAS unsigned char* lds, int wid, int lane) const {
        typedef float f32x2v __attribute__((ext_vector_type(2)));
        const PG8_LAS f32x2v* S = (const PG8_LAS f32x2v*)(lds + 8192);
        const int col0 = u.pn * BM + wc * 32 + 4 * fq;
#pragma unroll
        for (int bj = 0; bj < 2; ++bj)
#pragma unroll
            for (int n = 0; n < 2; ++n) { const f32x4 bv = bias ? *(const f32x4*)(bias + col0 + bj * HALF + n * 16) : (f32x4){0.f, 0.f, 0.f, 0.f};
#pragma unroll
                for (int ai = 0; ai < 2; ++ai)
#pragma unroll
                    for (int m = 0; m < 4; ++m) acc[ai][bj][m][n] += bv; }
        f32x4 pre[4][2][2];
#pragma unroll
        for (int m = 0; m < 4; ++m) { const size_t off = (size_t)(u.pm * BM + wr * 64 + m * 16 + fr) * ldc + col0;
#pragma unroll
            for (int bj = 0; bj < 2; ++bj)
#pragma unroll
                for (int n = 0; n < 2; ++n) pre[m][bj][n] = *(const f32x4*)(base + off + bj * HALF + n * 16); }
        const bool bad = st.run(acc, u, wr, wc, fr, fq, lds, wid, lane) || poison != 0u;
        const float qnan = __builtin_nanf("");
#pragma unroll
        for (int ai = 0; ai < 2; ++ai)
#pragma unroll
            for (int m = 0; m < 4; ++m) { const int r = ai * HALF + wr * 64 + m * 16 + fr; const f32x2v sr = S[r]; const size_t off = (size_t)(u.pm * BM + r) * ldc + col0;
#pragma unroll
                for (int bj = 0; bj < 2; ++bj)
#pragma unroll
                    for (int n = 0; n < 2; ++n) { const f32x4 bs = ai == 0 ? pre[m][bj][n] : *(const f32x4*)(base + off + bj * HALF + n * 16); f32x4 o = bs + (acc[ai][bj][m][n] - sr.x) * sr.y;
                        if (bad) o = (f32x4){qnan, qnan, qnan, qnan}; *(f32x4*)(out + off + bj * HALF + n * 16) = o; }
                if (m & 1) asm volatile("" ::: "memory"); }
    }
};
struct EpiLnResLn {
    static constexpr bool PERM = false, AFTER_DRAIN = true;
    const float* base; float* out; bf16_t* xn; int ldc; const float* bias; PanelStats st1, st2; unsigned poison;
    __device__ __forceinline__ void fused(f32x4 (&acc)[2][2][4][2], const Unit& u, int wr, int wc, int fr, int fq, PG8_LAS unsigned char* lds, int wid, int lane) const {
        typedef float f32x2v __attribute__((ext_vector_type(2))); typedef unsigned u32x2v __attribute__((ext_vector_type(2)));
        const PG8_LAS f32x2v* S = (const PG8_LAS f32x2v*)(lds + 8192);
        const int col0 = u.pn * BM + wc * 32 + 4 * fq;
#pragma unroll
        for (int bj = 0; bj < 2; ++bj)
#pragma unroll
            for (int n = 0; n < 2; ++n) { const f32x4 bv = bias ? *(const f32x4*)(bias + col0 + bj * HALF + n * 16) : (f32x4){0.f, 0.f, 0.f, 0.f};
#pragma unroll
                for (int ai = 0; ai < 2; ++ai)
#pragma unroll
                    for (int m = 0; m < 4; ++m) acc[ai][bj][m][n] += bv; }
        bool bad = st1.run(acc, u, wr, wc, fr, fq, lds, wid, lane) || poison != 0u;
        const float qnan = __builtin_nanf("");
#pragma unroll
        for (int ai = 0; ai < 2; ++ai)
#pragma unroll
            for (int m = 0; m < 4; ++m) { const int r = ai * HALF + wr * 64 + m * 16 + fr; const f32x2v sr = S[r]; const size_t off = (size_t)(u.pm * BM + r) * ldc + col0;
#pragma unroll
                for (int bj = 0; bj < 2; ++bj)
#pragma unroll
                    for (int n = 0; n < 2; ++n) { const f32x4 bs = *(const f32x4*)(base + off + bj * HALF + n * 16); acc[ai][bj][m][n] = bs + (acc[ai][bj][m][n] - sr.x) * sr.y; }
                asm volatile("" : "+v"(acc[ai][0][m][0]), "+v"(acc[ai][0][m][1]), "+v"(acc[ai][1][m][0]), "+v"(acc[ai][1][m][1]));
                if (m & 1) asm volatile("" ::: "memory"); }
        const bool bad1 = bad;
        bad = st2.run(acc, u, wr, wc, fr, fq, lds, wid, lane) || bad;
#pragma unroll
        for (int ai = 0; ai < 2; ++ai)
#pragma unroll
            for (int m = 0; m < 4; ++m) { const int r = ai * HALF + wr * 64 + m * 16 + fr; const f32x2v sr = S[r]; const size_t off = (size_t)(u.pm * BM + r) * ldc + col0;
#pragma unroll
                for (int bj = 0; bj < 2; ++bj)
#pragma unroll
                    for (int n = 0; n < 2; ++n) { const f32x4 x1 = acc[ai][bj][m][n]; *(f32x4*)(out + off + bj * HALF + n * 16) = bad1 ? (f32x4){qnan, qnan, qnan, qnan} : x1;
                        const f32x4 o = (x1 - sr.x) * sr.y; u32x2v w; w.x = cvt_pk_bf16(o[0], o[1]); w.y = cvt_pk_bf16(o[2], o[3]);
                        if (bad) { w.x = 0x7fc07fc0u; w.y = 0x7fc07fc0u; } *(u32x2v*)(xn + off + bj * HALF + n * 16) = w; }
                asm volatile("" ::: "memory"); }
    }
};

template <class Epi, class Sched, bool ALIGN_EPI = false, bool SP2 = false>
__device__ __forceinline__ void gemm_phase(PG8_LAS unsigned char* lds, const Gemm g, const Sched& S, const Epi& E) {
    const int tid = threadIdx.x, wid = __builtin_amdgcn_readfirstlane(tid >> 6), lane = tid & 63, wr = wid >> 2, wc = wid & 3, fr = lane & 15, fq = lane >> 4;
    const int K = g.K, nt = K / BK;
    unsigned voffA[2], voffB[2];
#pragma unroll
    for (int i = 0; i < 2; ++i) { int R, C; stage_rc(tid * 16 + i * 8192, R, C); const int Rb = Epi::PERM ? ((R & ~31) + perm32(R & 31)) : R;
        voffA[i] = (unsigned)(R * K + C) * 2u; voffB[i] = (unsigned)(Rb * K + C) * 2u; }
    const size_t kstep = (size_t)(BK * 2);
    const size_t hstep = (size_t)HALF * K * 2;
    const size_t tstep = 2 * hstep;
    const unsigned ldsw = (unsigned)wid * 1024u;
    const int aoff = lds_byte(wr * 64 + fr, fq * 8), boff = lds_byte(wc * 32 + fr, fq * 8);
#define PG8_SA(b, h) (((b) * 2 + (h)) * HTB)
#define PG8_SB(b, h) ((4 + (b) * 2 + (h)) * HTB)
#define PG8_STAGE(bufoff, gbase, voff) do { _Pragma("unroll") for (int _i = 0; _i < 2; ++_i) \
        __builtin_amdgcn_global_load_lds((const unsigned*)((const char*)(gbase) + (voff)[_i]), (PG8_LAS unsigned*)(lds + (bufoff) + ldsw + _i * 8192), 16, 0, 0); } while (0)
#define PG8_LDA(dst, b, h) do { _Pragma("unroll") for (int m = 0; m < 4; ++m) _Pragma("unroll") for (int k = 0; k < 2; ++k) dst[m][k] = *(const PG8_LAS bf16x8*)(lds + PG8_SA(b, h) + aoff + m * 2048 + k * 1024); } while (0)
#define PG8_LDB(dst, b, h) do { _Pragma("unroll") for (int n = 0; n < 2; ++n) _Pragma("unroll") for (int k = 0; k < 2; ++k) dst[n][k] = *(const PG8_LAS bf16x8*)(lds + PG8_SB(b, h) + boff + n * 2048 + k * 1024); } while (0)
#define PG8_MMA(ai, bj, At, Bt) do { __builtin_amdgcn_s_setprio(1); _Pragma("unroll") for (int m = 0; m < 4; ++m) _Pragma("unroll") for (int n = 0; n < 2; ++n) _Pragma("unroll") for (int k = 0; k < 2; ++k) \
        acc[ai][bj][m][n] = __builtin_amdgcn_mfma_f32_16x16x32_bf16(Bt[n][k], At[m][k], acc[ai][bj][m][n], 0, 0, 0); __builtin_amdgcn_s_setprio(0); } while (0)
#define PG8_WAIT_V(n) asm volatile("s_waitcnt vmcnt(" #n ")" ::: "memory")
#define PG8_WAIT_L(n) asm volatile("s_waitcnt lgkmcnt(" #n ")" ::: "memory")
#define PG8_BAR __builtin_amdgcn_s_barrier()
#define PG8_SCHED __builtin_amdgcn_sched_barrier(0)
    Unit cur, nxt; int ui = 0;
    if (!S.next(0, cur)) return;
    f32x4 acc[2][2][4][2];
#pragma unroll
    for (int a = 0; a < 2; ++a)
#pragma unroll
        for (int b = 0; b < 2; ++b)
#pragma unroll
            for (int m = 0; m < 4; ++m)
#pragma unroll
                for (int n = 0; n < 2; ++n) acc[a][b][m][n] = (f32x4){0.f, 0.f, 0.f, 0.f};
    bf16x8 At[4][2], B0[2][2], B1[2][2];
    const char* cA = (const char*)g.A + (size_t)cur.pm * tstep; const char* cB = (const char*)g.Bt + (size_t)cur.pn * tstep;
    S.a_ready(cur);
    if constexpr (SP2) {
        PG8_STAGE(PG8_SB(0, 0), cB, voffB); PG8_STAGE(PG8_SB(0, 1), cB + hstep, voffB); PG8_STAGE(PG8_SA(0, 0), cA, voffA); PG8_STAGE(PG8_SA(0, 1), cA + hstep, voffA);
        if (wr == 1) PG8_BAR;
        PG8_WAIT_V(2); PG8_BAR;
        PG8_STAGE(PG8_SB(1, 0), cB + kstep, voffB); PG8_STAGE(PG8_SA(1, 0), cA + kstep, voffA); PG8_STAGE(PG8_SB(1, 1), cB + hstep + kstep, voffB);
        PG8_WAIT_V(6); PG8_BAR;
    } else {
        PG8_STAGE(PG8_SB(0, 0), cB, voffB); PG8_STAGE(PG8_SA(0, 0), cA, voffA); PG8_STAGE(PG8_SB(0, 1), cB + hstep, voffB); PG8_STAGE(PG8_SA(0, 1), cA + hstep, voffA);
        if (wr == 1) PG8_BAR;
        PG8_WAIT_V(4); PG8_BAR;
        PG8_STAGE(PG8_SB(1, 0), cB + kstep, voffB); PG8_STAGE(PG8_SA(1, 0), cA + kstep, voffA); PG8_STAGE(PG8_SB(1, 1), cB + hstep + kstep, voffB);
        PG8_WAIT_V(6); PG8_BAR;
    }
    for (;;) {
        const bool has_next = S.next(ui + 1, nxt);
        const char* nA = has_next ? (const char*)g.A + (size_t)nxt.pm * tstep : cA; const char* nB = has_next ? (const char*)g.Bt + (size_t)nxt.pn * tstep : cB;
        for (int t = 0; t < nt; t += 2) {
            const bool last = (t == nt - 2);
            const char* a1 = cA + (size_t)(t + 1) * kstep;
            const char* a2 = last ? nA : cA + (size_t)(t + 2) * kstep; const char* b2 = last ? nB : cB + (size_t)(t + 2) * kstep;
            const char* a3 = a2 + kstep; const char* b3 = b2 + kstep;
            if (last && has_next) S.a_ready(nxt);
            if constexpr (SP2) {
            PG8_LDB(B0, 0, 0); PG8_LDB(B1, 0, 1); PG8_SCHED; PG8_LDA(At, 0, 0); PG8_STAGE(PG8_SA(1, 1), a1 + hstep, voffA);
            PG8_WAIT_V(8); PG8_WAIT_L(0); PG8_BAR; PG8_MMA(0, 0, At, B0); PG8_MMA(0, 1, At, B1); PG8_BAR; PG8_SCHED;
            PG8_LDA(At, 0, 1); PG8_STAGE(PG8_SB(0, 0), b2, voffB); PG8_STAGE(PG8_SB(0, 1), b2 + hstep, voffB); PG8_STAGE(PG8_SA(0, 0), a2, voffA);
            PG8_WAIT_V(8); PG8_WAIT_L(0); PG8_BAR; PG8_MMA(1, 0, At, B0); PG8_MMA(1, 1, At, B1); PG8_BAR; PG8_SCHED;
            PG8_LDB(B0, 1, 0); PG8_LDB(B1, 1, 1); PG8_SCHED; PG8_LDA(At, 1, 0); PG8_STAGE(PG8_SA(0, 1), a2 + hstep, voffA);
            PG8_WAIT_V(8); PG8_WAIT_L(0); PG8_BAR; PG8_MMA(0, 0, At, B0); PG8_MMA(0, 1, At, B1); PG8_BAR; PG8_SCHED;
            PG8_LDA(At, 1, 1); PG8_STAGE(PG8_SB(1, 0), b3, voffB); PG8_STAGE(PG8_SB(1, 1), b3 + hstep, voffB); PG8_STAGE(PG8_SA(1, 0), a3, voffA);
            PG8_WAIT_V(8); PG8_WAIT_L(0); PG8_BAR; PG8_MMA(1, 0, At, B0); PG8_MMA(1, 1, At, B1); PG8_BAR; PG8_SCHED;
            } else {
            PG8_LDB(B0, 0, 0); PG8_SCHED; PG8_LDA(At, 0, 0); PG8_STAGE(PG8_SA(1, 1), a1 + hstep, voffA);
            PG8_WAIT_L(8); PG8_BAR; PG8_WAIT_L(0); PG8_MMA(0, 0, At, B0); PG8_BAR; PG8_SCHED;
            PG8_LDB(B1, 0, 1); PG8_STAGE(PG8_SB(0, 0), b2, voffB);
            PG8_BAR; PG8_WAIT_L(0); PG8_MMA(0, 1, At, B1); PG8_BAR;
            PG8_LDA(At, 0, 1); PG8_STAGE(PG8_SA(0, 0), a2, voffA);
            PG8_BAR; PG8_WAIT_L(0); PG8_MMA(1, 0, At, B0); PG8_BAR; PG8_SCHED;
            PG8_STAGE(PG8_SB(0, 1), b2 + hstep, voffB);
            PG8_WAIT_V(6); PG8_BAR; PG8_MMA(1, 1, At, B1); PG8_BAR;
            PG8_LDB(B0, 1, 0); PG8_SCHED; PG8_LDA(At, 1, 0); PG8_STAGE(PG8_SA(0, 1), a2 + hstep, voffA);
            PG8_WAIT_L(8); PG8_BAR; PG8_WAIT_L(0); PG8_MMA(0, 0, At, B0); PG8_BAR; PG8_SCHED;
            PG8_LDB(B1, 1, 1); PG8_STAGE(PG8_SB(1, 0), b3, voffB);
            PG8_BAR; PG8_WAIT_L(0); PG8_MMA(0, 1, At, B1); PG8_BAR;
            PG8_LDA(At, 1, 1); PG8_STAGE(PG8_SA(1, 0), a3, voffA);
            PG8_BAR; PG8_WAIT_L(0); PG8_MMA(1, 0, At, B0); PG8_BAR; PG8_SCHED;
            PG8_STAGE(PG8_SB(1, 1), b3 + hstep, voffB);
            PG8_WAIT_V(6); PG8_BAR; PG8_MMA(1, 1, At, B1); PG8_BAR;
            }
        }
        if constexpr (ALIGN_EPI) { if (wr == 0) PG8_BAR; }
        if constexpr (!Epi::AFTER_DRAIN) { E(acc, cur, wr, wc, fr, fq); S.done(cur); }
        if (!has_next) break;
#pragma unroll
        for (int a = 0; a < 2; ++a)
#pragma unroll
            for (int b = 0; b < 2; ++b)
#pragma unroll
                for (int m = 0; m < 4; ++m)
#pragma unroll
                    for (int n = 0; n < 2; ++n) acc[a][b][m][n] = (f32x4){0.f, 0.f, 0.f, 0.f};
        cur = nxt; cA = nA; cB = nB; ++ui;
        if constexpr (ALIGN_EPI) { if (wr == 1) PG8_BAR; }
    }
    PG8_WAIT_V(0);
    if constexpr (!ALIGN_EPI) { if (wr == 0) PG8_BAR; }
    PG8_BAR;
    if constexpr (Epi::AFTER_DRAIN) { E.fused(acc, cur, wr, wc, fr, fq, lds, wid, lane); S.done(cur); }
#undef PG8_SA
#undef PG8_SB
#undef PG8_STAGE
#undef PG8_LDA
#undef PG8_LDB
#undef PG8_MMA
#undef PG8_WAIT_V
#undef PG8_WAIT_L
#undef PG8_BAR
#undef PG8_SCHED
}
}

#define DI __device__ __forceinline__
#define LAS __attribute__((address_space(3)))
typedef unsigned short bf16;
typedef pg8::f32x4 f32x4;
typedef pg8::bf16x8 bf16x8;
typedef pg8::u32x4 u32x4;
typedef float f32x16 __attribute__((ext_vector_type(16)));
typedef float f32x2_t __attribute__((ext_vector_type(2)));
typedef __bf16 bf16x2_t __attribute__((ext_vector_type(2)));
typedef unsigned u32x2 __attribute__((ext_vector_type(2)));
#define MFMA32(a, b, c) __builtin_amdgcn_mfma_f32_32x32x16_bf16((a), (b), (c), 0, 0, 0)

#ifndef MK_PER_PHASE
#define MK_PER_PHASE 0
#endif

constexpr int MP = 16384, MS = 256, M = MP + MS, D = 1024, FF = 2688, NGLA = 3072, NCH = 288, SEQ = 2048;
constexpr float EPS = 1e-6f;
constexpr int NPHASE = 16;
constexpr size_t MiB = 1u << 20;
constexpr size_t WS_SSQ = 0;
constexpr size_t WS_BAR = 1 * MiB;
constexpr size_t W_FI = 2 * MiB;
constexpr size_t W_FO = W_FI + 42 * MiB;
constexpr size_t W_GI = W_FO + 21 * MiB;
constexpr size_t W_GO = W_GI + 6 * MiB;
constexpr size_t W_KV = W_GO + 2 * MiB;
constexpr size_t W_Q = W_KV + 1 * MiB;
constexpr size_t W_AO = W_Q + 1536 * 1024;
constexpr size_t W_GLR = W_AO + 1536 * 1024;
constexpr size_t W_ROPE = W_GLR + 65536;
constexpr size_t WS_XB = 78 * MiB;
constexpr size_t WS_U1 = 111 * MiB;
constexpr size_t WS_U2 = 209 * MiB;
constexpr size_t WS_U3 = 299 * MiB;
constexpr size_t WS_LSE = 332 * MiB;
constexpr size_t WS_END = 333 * MiB;
static_assert(W_ROPE + 2056 * 32 * 8 <= WS_XB, "ws map");
constexpr size_t O_Y = 0, O_SP = (size_t)M * D, O_SS = O_SP + 1048576, O_KP = O_SS + 4194304, O_VP = O_KP + 4194304, O_KS = O_VP + 4194304, O_VS = O_KS + 65536;

constexpr int LDS_BYTES = 147456;

struct Args { const float* in[19]; float* out; unsigned char* ws; int ph_lo, ph_hi; };

DI float bf2f(bf16 b) { return __uint_as_float((unsigned)b << 16); }
DI unsigned cvtpk(float lo, float hi) { f32x2_t v = {lo, hi}; bf16x2_t b = __builtin_convertvector(v, bf16x2_t); return __builtin_bit_cast(unsigned, b); }
DI bf16 f2bf(float f) { return (bf16)(cvtpk(f, 0.f) & 0xffffu); }
DI float wave_sum(float v) {
#pragma unroll
    for (int o = 1; o < 64; o <<= 1) v += __shfl_xor(v, o);
    return v;
}
DI float wave_max(float v) {
#pragma unroll
    for (int o = 1; o < 64; o <<= 1) v = fmaxf(v, __shfl_xor(v, o));
    return v;
}
DI int swz(int x) { return (x & ~12) | ((x & 4) << 1) | ((x & 8) >> 1); }
DI int crow(int reg, int h) { return (reg & 3) + 8 * (reg >> 2) + 4 * h; }
template <int S> DI bf16x8 pack8(const f32x16& x) {
    u32x4 p; p.x = cvtpk(x[8 * S], x[8 * S + 1]); p.y = cvtpk(x[8 * S + 2], x[8 * S + 3]); p.z = cvtpk(x[8 * S + 4], x[8 * S + 5]); p.w = cvtpk(x[8 * S + 6], x[8 * S + 7]);
    return __builtin_bit_cast(bf16x8, p);
}
DI float silu(float x) { return x / (1.f + __expf(-x)); }

struct EpiSwiGLU {
    static constexpr bool PERM = false, AFTER_DRAIN = false;
    bf16* O; const float* ssq;
    DI void operator()(const f32x4 (&acc)[2][2][4][2], const pg8::Unit& u, int wr, int wc, int fr, int fq) const {
#pragma unroll
        for (int ai = 0; ai < 2; ++ai)
#pragma unroll
            for (int m = 0; m < 4; ++m) {
                const int row = u.pm * 256 + ai * 128 + wr * 64 + m * 16 + fr;
                const float rstd = rsqrtf(ssq[row] * (1.f / D) + EPS);
#pragma unroll
                for (int bj = 0; bj < 2; ++bj) {
                    const f32x4 g = acc[ai][bj][m][0] * rstd, uu = acc[ai][bj][m][1] * rstd;
                    u32x2 w; w.x = cvtpk(silu(g[0]) * uu[0], silu(g[1]) * uu[1]); w.y = cvtpk(silu(g[2]) * uu[2], silu(g[3]) * uu[3]);
                    *(u32x2*)(O + (size_t)row * FF + u.pn * 128 + bj * 64 + wc * 16 + fq * 4) = w;
                }
            }
    }
};
struct EpiResid {
    static constexpr bool PERM = false, AFTER_DRAIN = false;
    float* X; bf16* XB; float* ssq_out; float scale;
    DI void operator()(const f32x4 (&acc)[2][2][4][2], const pg8::Unit& u, int wr, int wc, int fr, int fq) const {
#pragma unroll
        for (int ai = 0; ai < 2; ++ai)
#pragma unroll
            for (int m = 0; m < 4; ++m) {
                const int row = u.pm * 256 + ai * 128 + wr * 64 + m * 16 + fr;
                float ss = 0.f;
#pragma unroll
                for (int bj = 0; bj < 2; ++bj)
#pragma unroll
                    for (int n = 0; n < 2; ++n) {
                        const size_t off = (size_t)row * D + u.pn * 256 + bj * 128 + wc * 32 + n * 16 + fq * 4;
                        f32x4 v = *(const f32x4*)(X + off) + acc[ai][bj][m][n] * scale;
                        *(f32x4*)(X + off) = v;
                        ss += (v[0] * v[0] + v[1] * v[1]) + (v[2] * v[2] + v[3] * v[3]);
                        if (XB) { u32x2 w; w.x = cvtpk(v[0], v[1]); w.y = cvtpk(v[2], v[3]); *(u32x2*)(XB + off) = w; }
                    }
                if (ssq_out) { ss += __shfl_xor(ss, 16); ss += __shfl_xor(ss, 32); if (fq == 0) atomicAdd(ssq_out + row, ss); }
                asm volatile("" ::: "memory");
            }
    }
};
struct EpiScale {
    static constexpr bool PERM = false, AFTER_DRAIN = false;
    bf16* Ob; float* Of; int ldc; const float* ssq;
    DI void operator()(const f32x4 (&acc)[2][2][4][2], const pg8::Unit& u, int wr, int wc, int fr, int fq) const {
#pragma unroll
        for (int ai = 0; ai < 2; ++ai)
#pragma unroll
            for (int m = 0; m < 4; ++m) {
                const int row = u.pm * 256 + ai * 128 + wr * 64 + m * 16 + fr;
                const float rstd = rsqrtf(ssq[row] * (1.f / D) + EPS);
#pragma unroll
                for (int bj = 0; bj < 2; ++bj)
#pragma unroll
                    for (int n = 0; n < 2; ++n) {
                        const size_t off = (size_t)row * ldc + u.pn * 256 + bj * 128 + wc * 32 + n * 16 + fq * 4;
                        const f32x4 v = acc[ai][bj][m][n] * rstd;
                        if (Ob) { u32x2 w; w.x = cvtpk(v[0], v[1]); w.y = cvtpk(v[2], v[3]); *(u32x2*)(Ob + off) = w; }
                        else *(f32x4*)(Of + off) = v;
                    }
            }
    }
};

template <int MODE> DI int src_col(int n) {
    if (MODE == 1) { const int G = n >> 5, w = n & 31; return w < 16 ? G * 16 + w : FF + G * 16 + (w - 16); }
    if (MODE == 2) return n < 2048 ? n : n + 16;
    return n;
}
template <int MODE> DI void transpose_item(const float* W, int K, int ldw, int Ndst, bf16* WT, const float* gain, LAS float* scr, int item, int lane) {
    const int nblk = Ndst / 32, kb = item / nblk, nb = item % nblk, k0 = 64 * kb, n0 = 32 * nb;
    const int sc = src_col<MODE>(n0 + (lane & 31));
#pragma unroll 8
    for (int i = 0; i < 32; ++i) { const int kk = 2 * i + (lane >> 5); const float g = gain ? gain[k0 + kk] : 1.f; scr[kk * 33 + (lane & 31)] = W[(size_t)(k0 + kk) * ldw + sc] * g; }
    asm volatile("s_waitcnt lgkmcnt(0)" ::: "memory");
    const int c = lane & 7;
#pragma unroll
    for (int j = 0; j < 4; ++j) { const int n = (lane >> 3) + 8 * j; const LAS float* s = scr + (8 * c) * 33 + n;
        u32x4 o; o.x = cvtpk(s[0 * 33], s[1 * 33]); o.y = cvtpk(s[2 * 33], s[3 * 33]); o.z = cvtpk(s[4 * 33], s[5 * 33]); o.w = cvtpk(s[6 * 33], s[7 * 33]);
        *(u32x4*)(WT + (size_t)(n0 + n) * K + k0 + 8 * c) = o; }
    asm volatile("s_waitcnt lgkmcnt(0)" ::: "memory");
}

DI void p0_prologue(const Args& a, LAS unsigned char* lds, int tid, int lane, int wave) {
    unsigned char* ws = a.ws;
    LAS float* scr = (LAS float*)(lds + wave * 16384);
    const int G = gridDim.x, gw = blockIdx.x * 8 + wave, NGW = G * 8;
    const float* gains = a.in[5];
    constexpr int I_FI = 16 * 168, I_FO = 42 * 32, I_GI = 16 * 96, I_GO = 16 * 32, I_KV = 16 * 16, I_Q = 16 * 24, I_AO = 12 * 32;
    constexpr int NITEMS = 4 * I_FI + 4 * I_FO + I_GI + I_GO + I_KV + I_Q + I_AO;
    for (int it = gw; it < NITEMS; it += NGW) {
        int r = it;
        if (r < 4 * I_FI) { const int mi = r / I_FI, l = mi >> 1, i = mi & 1; transpose_item<1>(a.in[6] + (size_t)mi * D * 2 * FF, D, 2 * FF, 2 * FF, (bf16*)(ws + W_FI) + (size_t)mi * 2 * FF * D, gains + (l * 3 + (i ? 2 : 0)) * D, scr, r % I_FI, lane); continue; } r -= 4 * I_FI;
        if (r < 4 * I_FO) { const int mi = r / I_FO; transpose_item<0>(a.in[7] + (size_t)mi * FF * D, FF, D, D, (bf16*)(ws + W_FO) + (size_t)mi * D * FF, nullptr, scr, r % I_FO, lane); continue; } r -= 4 * I_FO;
        if (r < I_GI) { transpose_item<2>(a.in[8], D, 3088, NGLA, (bf16*)(ws + W_GI), gains + 1 * D, scr, r, lane); continue; } r -= I_GI;
        if (r < I_GO) { transpose_item<0>(a.in[12], D, D, D, (bf16*)(ws + W_GO), nullptr, scr, r, lane); continue; } r -= I_GO;
        if (r < I_KV) { transpose_item<0>(a.in[14], D, 512, 512, (bf16*)(ws + W_KV), a.in[13], scr, r, lane); continue; } r -= I_KV;
        if (r < I_Q) { transpose_item<0>(a.in[16], D, 768, 768, (bf16*)(ws + W_Q), gains + 4 * D, scr, r, lane); continue; } r -= I_Q;
        transpose_item<0>(a.in[18], 768, D, D, (bf16*)(ws + W_AO), nullptr, scr, r, lane);
    }
    float* ssq = (float*)(ws + WS_SSQ);
    for (int m = gw; m < M; m += NGW) {
        const float* xr = m < MP ? a.in[0] + (size_t)m * D : a.in[1] + (size_t)(m - MP) * D;
        float s = 0.f;
#pragma unroll
        for (int j = 0; j < 4; ++j) {
            const f32x4 v = *((const f32x4*)xr + lane + 64 * j);
            *((f32x4*)(a.out + (size_t)m * D) + lane + 64 * j) = v;
            u32x2 w; w.x = cvtpk(v[0], v[1]); w.y = cvtpk(v[2], v[3]);
            *((u32x2*)((bf16*)(ws + WS_XB) + (size_t)m * D) + lane + 64 * j) = w;
            s += (v[0] * v[0] + v[1] * v[1]) + (v[2] * v[2] + v[3] * v[3]);
        }
        s = wave_sum(s);
        if (lane == 0) ssq[m] = s;
    }
    const int gt = blockIdx.x * 512 + tid, NGT = G * 512;
    for (int i = gt; i < 5 * M; i += NGT) ssq[M + i] = 0.f;
    for (int i = gt; i < 2056 * 32; i += NGT) {
        const int p = i >> 5, f = i & 31; const int pos = p < 2048 ? p : 8192 + (p - 2048);
        const double inv = pow(10000.0, -(double)f / 32.0); double sn, cs; sincos((double)pos * inv, &sn, &cs);
        ((float*)(ws + W_ROPE))[2 * i] = (float)cs; ((float*)(ws + W_ROPE))[2 * i + 1] = (float)sn;
    }
    for (int i = gt; i < 32 * D; i += NGT) { const int c = i >> 10, k = i & 1023; ((bf16*)(ws + W_GLR))[i] = c < 16 ? f2bf(a.in[8][(size_t)k * 3088 + 2048 + c] * gains[1 * D + k]) : (bf16)0; }
}

constexpr size_t U2_QIMG = 0, U2_PBE = 18 * MiB, U2_KDIMG = 36 * MiB, U2_VT = 54 * MiB;
constexpr int PBE_BYTES = 7168;
DI float logsig16(float z) { return -(fmaxf(-z, 0.f) + __logf(1.f + __expf(-fabsf(z)))) * (1.f / 16.f); }
DI void gla_prep(const Args& a, LAS unsigned char* lds, int tid, int lane, int wave) {
    unsigned char* ws = a.ws;
    LAS unsigned char* QI = lds;
    LAS unsigned char* KI = lds + 65536;
    LAS float* glr = (LAS float*)(lds + 131072);
    const bf16* qkvr = (const bf16*)(ws + WS_U1);
    const bf16* XBp = (const bf16*)(ws + WS_XB);
    const bf16* WgT = (const bf16*)(ws + W_GLR);
    unsigned char* QIMG = ws + WS_U2 + U2_QIMG; unsigned char* PBE = ws + WS_U2 + U2_PBE; unsigned char* KDIMG = ws + WS_U2 + U2_KDIMG; bf16* VT = (bf16*)(ws + WS_U2 + U2_VT);
    const float* ssq1 = (const float*)(ws + WS_SSQ) + 1 * M;
    const int r = lane & 31, hh = lane >> 5;
    for (int ch = blockIdx.x; ch < NCH; ch += gridDim.x) {
        const bool smp = ch >= 256; const int T = smp ? 8 : 64; const int row0 = smp ? MP + 8 * (ch - 256) : 64 * ch;
        {
            f32x16 P0, P1;
#pragma unroll
            for (int i = 0; i < 16; ++i) { P0[i] = 0.f; P1[i] = 0.f; }
            const bf16* x0 = XBp + (size_t)(row0 + r) * D + 128 * wave + 8 * hh;
            const bf16* wg = WgT + (size_t)r * D + 128 * wave + 8 * hh;
#pragma unroll
            for (int ks = 0; ks < 8; ++ks) {
                const bf16x8 bw = *(const bf16x8*)(wg + 16 * ks);
                P0 = MFMA32(*(const bf16x8*)(x0 + 16 * ks), bw, P0);
                P1 = MFMA32(*(const bf16x8*)(x0 + (size_t)32 * D + 16 * ks), bw, P1);
            }
            LAS float* part = (LAS float*)QI + wave * 1024;
            if (r < 16) {
#pragma unroll
                for (int i = 0; i < 16; ++i) { part[crow(i, hh) * 16 + r] = P0[i]; part[(32 + crow(i, hh)) * 16 + r] = P1[i]; }
            }
        }
        __syncthreads();
#pragma unroll
        for (int k2 = 0; k2 < 2; ++k2) {
            const int idx = tid + 512 * k2, t = idx >> 4;
            float sacc = 0.f;
#pragma unroll
            for (int w8 = 0; w8 < 8; ++w8) sacc += ((LAS float*)QI)[w8 * 1024 + idx];
            const float rstd = t < T ? rsqrtf(ssq1[row0 + t] * (1.f / D) + EPS) : 0.f;
            glr[idx] = t < T ? sacc * rstd : 0.f;
        }
        __syncthreads();
        {
            const int col = tid, h = col >> 7, d = col & 127;
            float w2[16];
#pragma unroll
            for (int i = 0; i < 16; ++i) w2[i] = a.in[9][i * 512 + col];
            const float bias = a.in[10][col];
            float total = 0.f;
            for (int t = 0; t < T; ++t) { float z = bias;
#pragma unroll
                for (int i = 0; i < 16; ++i) z += glr[t * 16 + i] * w2[i];
                total += logsig16(z); }
            float cum = 0.f;
            const int dp = swz(d), pc = dp >> 3, wi = dp & 7;
            LAS unsigned char* qi = QI + h * 16384 + wi * 2;
            LAS unsigned char* ki = KI + h * 16384 + wi * 2;
            unsigned char* kdrow = KDIMG + (size_t)(ch * 4 + h) * 16384 + d * 128;
            const int dsw = (d >> 1) & 7;
            for (int t16 = 0; t16 < 4; ++t16) {
                unsigned kd[8];
#pragma unroll
                for (int i = 0; i < 8; ++i) kd[i] = 0u;
                float qv[16], kv[16];
#pragma unroll
                for (int tt = 0; tt < 16; ++tt) { const int t = 16 * t16 + tt; const bool valid = t < T;
                    qv[tt] = valid ? bf2f(qkvr[(size_t)(row0 + t) * NGLA + col]) : 0.f; kv[tt] = valid ? bf2f(qkvr[(size_t)(row0 + t) * NGLA + 512 + col]) : 0.f; }
#pragma unroll
                for (int tt = 0; tt < 16; ++tt) {
                    const int t = 16 * t16 + tt;
                    if (t < T) { float z = bias;
#pragma unroll
                        for (int i = 0; i < 16; ++i) z += glr[t * 16 + i] * w2[i];
                        cum += logsig16(z); }
                    const int off = t * 256 + ((pc ^ tt) << 4);
                    *(LAS bf16*)(qi + off) = f2bf(qv[tt] * 0.08838834764831845f * __expf(cum));
                    *(LAS bf16*)(ki + off) = f2bf(kv[tt] * __expf(-cum));
                    const unsigned kdv = f2bf(kv[tt] * __expf(total - cum));
                    const int p = (tt & ~12) | ((tt & 4) << 1) | ((tt & 8) >> 1);
                    kd[p >> 1] |= kdv << (16 * (p & 1));
                }
                u32x4 o0, o1; o0.x = kd[0]; o0.y = kd[1]; o0.z = kd[2]; o0.w = kd[3]; o1.x = kd[4]; o1.y = kd[5]; o1.z = kd[6]; o1.w = kd[7];
                *(u32x4*)(kdrow + (((2 * t16) ^ dsw) << 4)) = o0; *(u32x4*)(kdrow + (((2 * t16 + 1) ^ dsw) << 4)) = o1;
            }
            *(float*)(PBE + (size_t)(ch * 4 + h) * PBE_BYTES + 6144 + d * 4) = __expf(total);
        }
#pragma unroll 1
        for (int rep = 0; rep < 2; ++rep) {
            const int vc = tid + 512 * rep, h = vc >> 8, vv = vc & 255;
            bf16* vt = VT + ((size_t)(ch * 4 + h) * 256 + vv) * 64;
            for (int t16 = 0; t16 < 4; ++t16) {
                unsigned kd[8];
#pragma unroll
                for (int i = 0; i < 8; ++i) kd[i] = 0u;
#pragma unroll
                for (int tt = 0; tt < 16; ++tt) {
                    const int t = 16 * t16 + tt;
                    const unsigned v = t < T ? (unsigned)qkvr[(size_t)(row0 + t) * NGLA + 1024 + vc] : 0u;
                    const int p = (tt & ~12) | ((tt & 4) << 1) | ((tt & 8) >> 1);
                    kd[p >> 1] |= v << (16 * (p & 1));
                }
                u32x4 o0, o1; o0.x = kd[0]; o0.y = kd[1]; o0.z = kd[2]; o0.w = kd[3]; o1.x = kd[4]; o1.y = kd[5]; o1.z = kd[6]; o1.w = kd[7];
                *(u32x4*)(vt + 16 * t16) = o0; *(u32x4*)(vt + 16 * t16 + 8) = o1;
            }
        }
        __syncthreads();
        {
            const int h = wave >> 1, half = wave & 1;
            const LAS unsigned char* qi = QI + h * 16384; const LAS unsigned char* ki = KI + h * 16384;
            unsigned char* pb = PBE + (size_t)(ch * 4 + h) * PBE_BYTES + lane * 16;
            f32x16 A0, A1;
#pragma unroll
            for (int i = 0; i < 16; ++i) { A0[i] = 0.f; A1[i] = 0.f; }
            if (half == 0) {
#pragma unroll
                for (int s = 0; s < 8; ++s) {
                    const int po = ((2 * s + hh) ^ (r & 15)) << 4;
                    const bf16x8 k0 = *(const LAS bf16x8*)(ki + r * 256 + po);
                    A0 = MFMA32(k0, *(const LAS bf16x8*)(qi + r * 256 + po), A0);
                    A1 = MFMA32(k0, *(const LAS bf16x8*)(qi + (32 + r) * 256 + po), A1);
                }
#pragma unroll
                for (int i = 0; i < 16; ++i) if (crow(i, hh) > r) A0[i] = 0.f;
                *(bf16x8*)(pb + 0 * 1024) = pack8<0>(A0); *(bf16x8*)(pb + 1 * 1024) = pack8<1>(A0);
                *(bf16x8*)(pb + 2 * 1024) = pack8<0>(A1); *(bf16x8*)(pb + 3 * 1024) = pack8<1>(A1);
            } else {
#pragma unroll
                for (int s = 0; s < 8; ++s) {
                    const int po = ((2 * s + hh) ^ (r & 15)) << 4;
                    A0 = MFMA32(*(const LAS bf16x8*)(ki + (32 + r) * 256 + po), *(const LAS bf16x8*)(qi + (32 + r) * 256 + po), A0);
                }
#pragma unroll
                for (int i = 0; i < 16; ++i) if (crow(i, hh) > r) A0[i] = 0.f;
                *(bf16x8*)(pb + 4 * 1024) = pack8<0>(A0); *(bf16x8*)(pb + 5 * 1024) = pack8<1>(A0);
            }
        }
        {
            unsigned char* dst = QIMG + (size_t)ch * 65536;
#pragma unroll
            for (int i = 0; i < 8; ++i) *(u32x4*)(dst + (i * 512 + tid) * 16) = *(const LAS u32x4*)(QI + (i * 512 + tid) * 16);
        }
        __syncthreads();
    }
}

constexpr int REC_SLOT = 40960, REC_SSQ = 81920;
DI void rec_stage(const unsigned char* QIMG, const unsigned char* KDIMG, const unsigned char* PBE, int ch, int h, LAS unsigned char* slot, int tid, int lane, int wave) {
    const unsigned char* q = QIMG + (size_t)(ch * 4 + h) * 16384; const unsigned char* k = KDIMG + (size_t)(ch * 4 + h) * 16384; const unsigned char* p = PBE + (size_t)(ch * 4 + h) * PBE_BYTES;
#pragma unroll
    for (int i = 0; i < 2; ++i) {
        __builtin_amdgcn_global_load_lds((const unsigned*)(q + (i * 512 + tid) * 16), (LAS unsigned*)(slot + i * 8192 + wave * 1024), 16, 0, 0);
        __builtin_amdgcn_global_load_lds((const unsigned*)(k + (i * 512 + tid) * 16), (LAS unsigned*)(slot + 16384 + i * 8192 + wave * 1024), 16, 0, 0);
    }
    if (wave < 7) __builtin_amdgcn_global_load_lds((const unsigned*)(p + tid * 16), (LAS unsigned*)(slot + 32768 + wave * 1024), 16, 0, 0);
}
DI void gla_rec(const Args& a, LAS unsigned char* lds, int tid, int lane, int wave) {
    unsigned char* ws = a.ws;
    LAS float* ssqbuf = (LAS float*)(lds + REC_SSQ);
    const bf16* qkvr = (const bf16*)(ws + WS_U1);
    const unsigned char* QIMG = ws + WS_U2 + U2_QIMG; const unsigned char* PBE = ws + WS_U2 + U2_PBE; const unsigned char* KDIMG = ws + WS_U2 + U2_KDIMG; const bf16* VT = (const bf16*)(ws + WS_U2 + U2_VT);
    bf16* AG = (bf16*)(ws + WS_U3);
    const float* gnorm = a.in[11];
    const int r = lane & 31, hh = lane >> 5, w = wave;
    for (int u = blockIdx.x; u < 160; u += gridDim.x) {
        const bool smp = u >= 32;
        int b, h, nchunk, chunk0, T;
        if (!smp) { b = u >> 2; h = u & 3; nchunk = 32; chunk0 = b * 32; T = 64; }
        else { const int uu = u - 32; b = uu >> 2; h = uu & 3; nchunk = 1; chunk0 = 256 + b; T = 8; }
        rec_stage(QIMG, KDIMG, PBE, chunk0, h, lds, tid, lane, wave);
        f32x16 S[4];
#pragma unroll
        for (int dt = 0; dt < 4; ++dt)
#pragma unroll
            for (int i = 0; i < 16; ++i) S[dt][i] = 0.f;
        if (smp) {
            const float* s0 = a.in[2] + ((size_t)(b * 4 + h) * 128 + 4 * hh) * 256 + 32 * w + r;
#pragma unroll
            for (int dt = 0; dt < 4; ++dt)
#pragma unroll
                for (int g = 0; g < 4; ++g) { const float* pp = s0 + (size_t)(32 * dt + 8 * g) * 256;
                    S[dt][4 * g] = pp[0]; S[dt][4 * g + 1] = pp[256]; S[dt][4 * g + 2] = pp[512]; S[dt][4 * g + 3] = pp[768];
                    asm volatile("" ::: "memory"); }
        }
        f32x4 gn[4];
#pragma unroll
        for (int g = 0; g < 4; ++g) gn[g] = *(const f32x4*)(gnorm + 32 * w + 8 * g + 4 * hh);
        bf16x8 vf[4];
        {
            const bf16* vt = VT + ((size_t)(chunk0 * 4 + h) * 256 + 32 * w) * 64;
#pragma unroll
            for (int js = 0; js < 4; ++js) vf[js] = *(const bf16x8*)(vt + r * 64 + 16 * js + 8 * hh);
        }
        asm volatile("s_waitcnt vmcnt(0)" ::: "memory");
        __syncthreads();
        for (int c = 0; c < nchunk; ++c) {
            const int ch = chunk0 + c; const int row0 = smp ? MP + 8 * b : b * SEQ + 64 * c;
            LAS unsigned char* cur = lds + (c & 1) * REC_SLOT;
            u32x2 rg[2][4];
            if (c + 1 < nchunk) rec_stage(QIMG, KDIMG, PBE, ch + 1, h, lds + ((c + 1) & 1) * REC_SLOT, tid, lane, wave);
#pragma unroll
            for (int it = 0; it < 2; ++it)
#pragma unroll
                for (int g = 0; g < 4; ++g) { const int tok = 32 * it + r; const size_t row = (size_t)row0 + (tok < T ? tok : 0);
                    rg[it][g] = *(const u32x2*)(qkvr + row * NGLA + 2048 + h * 256 + 32 * w + 8 * g + 4 * hh); }
            f32x16 O[2];
#pragma unroll
            for (int i = 0; i < 16; ++i) { O[0][i] = 0.f; O[1][i] = 0.f; }
#pragma unroll
            for (int s = 0; s < 8; ++s) {
                const int po = ((2 * s + hh) ^ (r & 15)) << 4;
                const bf16x8 ps = (s & 1) ? pack8<1>(S[s >> 1]) : pack8<0>(S[s >> 1]);
                O[0] = MFMA32(ps, *(const LAS bf16x8*)(cur + r * 256 + po), O[0]);
                O[1] = MFMA32(ps, *(const LAS bf16x8*)(cur + (32 + r) * 256 + po), O[1]);
            }
            {
                const LAS unsigned char* pb = cur + 32768 + lane * 16;
                O[0] = MFMA32(vf[0], *(const LAS bf16x8*)(pb + 0 * 1024), O[0]); O[0] = MFMA32(vf[1], *(const LAS bf16x8*)(pb + 1 * 1024), O[0]);
                O[1] = MFMA32(vf[0], *(const LAS bf16x8*)(pb + 2 * 1024), O[1]); O[1] = MFMA32(vf[1], *(const LAS bf16x8*)(pb + 3 * 1024), O[1]);
                O[1] = MFMA32(vf[2], *(const LAS bf16x8*)(pb + 4 * 1024), O[1]); O[1] = MFMA32(vf[3], *(const LAS bf16x8*)(pb + 5 * 1024), O[1]);
            }
            LAS float* sb = ssqbuf + (c & 1) * 512;
#pragma unroll
            for (int it = 0; it < 2; ++it) { float ss = 0.f;
#pragma unroll
                for (int i = 0; i < 16; ++i) ss += O[it][i] * O[it][i];
                ss += __shfl_xor(ss, 32);
                if (hh == 0) sb[w * 64 + 32 * it + r] = ss; }
#pragma unroll
            for (int dt = 0; dt < 4; ++dt) {
#pragma unroll
                for (int g = 0; g < 4; ++g) { const f32x4 el = *(const LAS f32x4*)(cur + 32768 + 6144 + (32 * dt + 8 * g + 4 * hh) * 4);
                    S[dt][4 * g] *= el[0]; S[dt][4 * g + 1] *= el[1]; S[dt][4 * g + 2] *= el[2]; S[dt][4 * g + 3] *= el[3]; }
#pragma unroll
                for (int js = 0; js < 4; ++js) { const bf16x8 kd = *(const LAS bf16x8*)(cur + 16384 + (32 * dt + r) * 128 + (((2 * js + hh) ^ ((r >> 1) & 7)) << 4)); S[dt] = MFMA32(kd, vf[js], S[dt]); }
            }
            if (c + 1 < nchunk) {
                const bf16* vt = VT + ((size_t)((ch + 1) * 4 + h) * 256 + 32 * w) * 64;
#pragma unroll
                for (int js = 0; js < 4; ++js) vf[js] = *(const bf16x8*)(vt + r * 64 + 16 * js + 8 * hh);
            }
            __syncthreads();
#pragma unroll
            for (int it = 0; it < 2; ++it) {
                float tot = 0.f;
#pragma unroll
                for (int ww = 0; ww < 8; ++ww) tot += sb[ww * 64 + 32 * it + r];
                const float rstd = rsqrtf(tot * (1.f / 256.f) + EPS);
                const int tok = 32 * it + r;
                if (tok < T) {
                    const size_t row = (size_t)row0 + tok;
#pragma unroll
                    for (int g = 0; g < 4; ++g) {
                        const int vb = 32 * w + 8 * g + 4 * hh;
                        const u32x2 rr = rg[it][g];
                        const float r0 = __uint_as_float(rr.x << 16), r1 = __uint_as_float(rr.x & 0xffff0000u), r2 = __uint_as_float(rr.y << 16), r3 = __uint_as_float(rr.y & 0xffff0000u);
                        u32x2 o; o.x = cvtpk(O[it][4 * g] * rstd * gn[g][0] * silu(r0), O[it][4 * g + 1] * rstd * gn[g][1] * silu(r1));
                        o.y = cvtpk(O[it][4 * g + 2] * rstd * gn[g][2] * silu(r2), O[it][4 * g + 3] * rstd * gn[g][3] * silu(r3));
                        *(u32x2*)(AG + row * D + h * 256 + vb) = o;
                    }
                }
            }
            asm volatile("s_waitcnt vmcnt(0)" ::: "memory");
            __syncthreads();
        }
        float* so = a.out + (smp ? O_SS : O_SP) + ((size_t)(b * 4 + h) * 128 + 4 * hh) * 256 + 32 * w + r;
#pragma unroll
        for (int dt = 0; dt < 4; ++dt)
#pragma unroll
            for (int g = 0; g < 4; ++g) { float* pp = so + (size_t)(32 * dt + 8 * g) * 256;
                pp[0] = S[dt][4 * g]; pp[256] = S[dt][4 * g + 1]; pp[512] = S[dt][4 * g + 2]; pp[768] = S[dt][4 * g + 3]; }
        __syncthreads();
    }
}

DI void kv_post_item(const Args& a, int item, int tid) {
    unsigned char* ws = a.ws;
    const float* kvraw = (const float*)(ws + WS_U2);
    bf16* Kb = (bf16*)(ws + WS_U3); bf16* VTd = Kb + (size_t)MP * 256;
    const float* rope = (const float*)(ws + W_ROPE);
    const int t = tid >> 3, sub = tid & 7, hd = sub & 3, isV = sub >> 2;
    const int row = 64 * item + t; const bool prompt = row < MP;
    const float* src = kvraw + (size_t)row * 512 + isV * 256 + hd * 64;
    float v[64];
#pragma unroll
    for (int i = 0; i < 16; ++i) { const f32x4 x = *(const f32x4*)(src + 4 * i); v[4 * i] = x[0]; v[4 * i + 1] = x[1]; v[4 * i + 2] = x[2]; v[4 * i + 3] = x[3]; }
    if (!isV) {
        float ss = 0.f;
#pragma unroll
        for (int i = 0; i < 64; ++i) ss += v[i] * v[i];
        const float rk = rsqrtf(ss * (1.f / 64.f) + EPS);
        const int pidx = prompt ? (row & 2047) : 2048 + ((row - MP) & 7);
        const float* kn = a.in[15];
#pragma unroll
        for (int i = 0; i < 32; ++i) {
            const float x1 = v[i] * rk * kn[i], x2 = v[i + 32] * rk * kn[i + 32];
            const float cs = rope[(pidx * 32 + i) * 2], sn = rope[(pidx * 32 + i) * 2 + 1];
            v[i] = x1 * cs - x2 * sn; v[i + 32] = x1 * sn + x2 * cs;
        }
        float* ok = prompt ? a.out + O_KP + (size_t)row * 256 + hd * 64 : a.out + O_KS + (size_t)(row - MP) * 256 + hd * 64;
#pragma unroll
        for (int i = 0; i < 16; ++i) { f32x4 x; x[0] = v[4 * i]; x[1] = v[4 * i + 1]; x[2] = v[4 * i + 2]; x[3] = v[4 * i + 3]; *(f32x4*)(ok + 4 * i) = x; }
        if (prompt) {
            bf16* kb = Kb + (size_t)row * 256 + hd * 64;
#pragma unroll
            for (int i = 0; i < 8; ++i) { u32x4 o; o.x = cvtpk(v[8 * i], v[8 * i + 1]); o.y = cvtpk(v[8 * i + 2], v[8 * i + 3]); o.z = cvtpk(v[8 * i + 4], v[8 * i + 5]); o.w = cvtpk(v[8 * i + 6], v[8 * i + 7]); *(u32x4*)(kb + 8 * i) = o; }
        }
    } else {
        float* ov = prompt ? a.out + O_VP + (size_t)row * 256 + hd * 64 : a.out + O_VS + (size_t)(row - MP) * 256 + hd * 64;
#pragma unroll
        for (int i = 0; i < 16; ++i) { f32x4 x; x[0] = v[4 * i]; x[1] = v[4 * i + 1]; x[2] = v[4 * i + 2]; x[3] = v[4 * i + 3]; *(f32x4*)(ov + 4 * i) = x; }
        if (prompt) {
            const int b = row >> 11, tk = row & 2047;
#pragma unroll
            for (int gi = 0; gi < 3; ++gi) {
                const int dl = gi == 0 ? 1 : (gi == 1 ? 4 : 16), L = SEQ / dl;
                const int pos = (tk % dl) * L + swz(tk / dl);
                bf16* vt = VTd + (size_t)gi * 8 * 4 * 64 * SEQ + ((size_t)(b * 4 + hd) * 64) * SEQ + pos;
#pragma unroll
                for (int i = 0; i < 64; ++i) vt[(size_t)i * SEQ] = f2bf(v[i]);
            }
        }
    }
}

DI void attn_tile(const Args& a, int b, int j, int g, int res, int a0, int lane) {
    unsigned char* ws = a.ws;
    const bf16* qraw = (const bf16*)(ws + WS_U1);
    const bf16* Kb = (const bf16*)(ws + WS_U3); const bf16* VTd = Kb + (size_t)MP * 256;
    float* OG = (float*)(ws + WS_U2); float* LSE = (float*)(ws + WS_LSE);
    const float* rope = (const float*)(ws + W_ROPE);
    const float* qn = a.in[17];
    const int r = lane & 31, hh = lane >> 5;
    const int dl = g == 0 ? 1 : (g == 1 ? 4 : 16), L = SEQ / dl;
    const int tq = dl * (a0 + r) + res; const size_t row = (size_t)b * SEQ + tq;
    const int qh = g * 4 + j;
    bf16x8 qf[4];
    {
        float x[4][8];
#pragma unroll
        for (int s = 0; s < 4; ++s) { const u32x4 v = *(const u32x4*)(qraw + row * 768 + qh * 64 + 16 * s + 8 * hh);
            x[s][0] = __uint_as_float(v.x << 16); x[s][1] = __uint_as_float(v.x & 0xffff0000u); x[s][2] = __uint_as_float(v.y << 16); x[s][3] = __uint_as_float(v.y & 0xffff0000u);
            x[s][4] = __uint_as_float(v.z << 16); x[s][5] = __uint_as_float(v.z & 0xffff0000u); x[s][6] = __uint_as_float(v.w << 16); x[s][7] = __uint_as_float(v.w & 0xffff0000u); }
        float ss = 0.f;
#pragma unroll
        for (int s = 0; s < 4; ++s)
#pragma unroll
            for (int e = 0; e < 8; ++e) ss += x[s][e] * x[s][e];
        ss += __shfl_xor(ss, 32);
        const float rq = rsqrtf(ss * (1.f / 64.f) + EPS) ;
#pragma unroll
        for (int s = 0; s < 2; ++s)
#pragma unroll
            for (int e = 0; e < 8; ++e) {
                const int i = 16 * s + 8 * hh + e;
                const float x1 = x[s][e] * rq * qn[i], x2 = x[s + 2][e] * rq * qn[i + 32];
                const float cs = rope[(tq * 32 + i) * 2], sn = rope[(tq * 32 + i) * 2 + 1];
                x[s][e] = (x1 * cs - x2 * sn) * 0.125f; x[s + 2][e] = (x1 * sn + x2 * cs) * 0.125f;
            }
#pragma unroll
        for (int s = 0; s < 4; ++s) { u32x4 p; p.x = cvtpk(x[s][0], x[s][1]); p.y = cvtpk(x[s][2], x[s][3]); p.z = cvtpk(x[s][4], x[s][5]); p.w = cvtpk(x[s][6], x[s][7]); qf[s] = __builtin_bit_cast(bf16x8, p); }
    }
    f32x16 ST[5];
#pragma unroll
    for (int kt = 0; kt < 5; ++kt) {
        int ks = a0 - 128 + 32 * kt + r; ks = ks < 0 ? 0 : ks;
        const bf16* kp = Kb + ((size_t)b * SEQ + dl * ks + res) * 256 + j * 64 + 8 * hh;
#pragma unroll
        for (int i = 0; i < 16; ++i) ST[kt][i] = 0.f;
#pragma unroll
        for (int s = 0; s < 4; ++s) { const bf16x8 kf = *(const bf16x8*)(kp + 16 * s); ST[kt] = MFMA32(kf, qf[s], ST[kt]); }
        asm volatile("" ::: "memory");
    }
    float mx = -INFINITY;
#pragma unroll
    for (int kt = 0; kt < 5; ++kt)
#pragma unroll
        for (int i = 0; i < 16; ++i) {
            const int krel = 32 * kt - 128 + crow(i, hh);
            const bool valid = (krel <= r) && (krel + 128 >= r) && (a0 + krel >= 0);
            ST[kt][i] = valid ? ST[kt][i] : -INFINITY;
            mx = fmaxf(mx, ST[kt][i]);
        }
    mx = fmaxf(mx, __shfl_xor(mx, 32));
    float den = 0.f;
#pragma unroll
    for (int kt = 0; kt < 5; ++kt)
#pragma unroll
        for (int i = 0; i < 16; ++i) { const float p = __expf(ST[kt][i] - mx); ST[kt][i] = p; den += p; }
    den += __shfl_xor(den, 32);
    f32x16 OT[2];
#pragma unroll
    for (int i = 0; i < 16; ++i) { OT[0][i] = 0.f; OT[1][i] = 0.f; }
    const bf16* vbase = VTd + (size_t)g * 8 * 4 * 64 * SEQ + ((size_t)(b * 4 + j) * 64 + r) * SEQ + res * L + 8 * hh;
#pragma unroll
    for (int kt = 0; kt < 5; ++kt) {
        const bf16x8 p0 = pack8<0>(ST[kt]), p1 = pack8<1>(ST[kt]);
        int s0 = a0 - 128 + 32 * kt; const int s0a = s0 < 0 ? 0 : s0; const int s0b = s0 + 16 < 0 ? 0 : s0 + 16;
        OT[0] = MFMA32(*(const bf16x8*)(vbase + s0a), p0, OT[0]);
        OT[1] = MFMA32(*(const bf16x8*)(vbase + (size_t)32 * SEQ + s0a), p0, OT[1]);
        OT[0] = MFMA32(*(const bf16x8*)(vbase + s0b), p1, OT[0]);
        OT[1] = MFMA32(*(const bf16x8*)(vbase + (size_t)32 * SEQ + s0b), p1, OT[1]);
        asm volatile("" ::: "memory");
    }
    const float inv = 1.f / den;
#pragma unroll
    for (int mt = 0; mt < 2; ++mt)
#pragma unroll
        for (int q = 0; q < 4; ++q) { f32x4 o; o[0] = OT[mt][4 * q] * inv; o[1] = OT[mt][4 * q + 1] * inv; o[2] = OT[mt][4 * q + 2] * inv; o[3] = OT[mt][4 * q + 3] * inv;
            *(f32x4*)(OG + row * 768 + qh * 64 + 32 * mt + 8 * q + 4 * hh) = o; }
    if (hh == 0) LSE[row * 12 + qh] = mx + __logf(den);
}

DI void attn_sample_unit(const Args& a, LAS unsigned char* lds, int unit, int lane, int wave) {
    unsigned char* ws = a.ws;
    const bf16* qraw = (const bf16*)(ws + WS_U1);
    bf16* AA = (bf16*)(ws + WS_U1 + 32 * MiB);
    const float* rope = (const float*)(ws + W_ROPE);
    const float* qn = a.in[17];
    LAS float* qs = (LAS float*)(lds + 8192 + wave * 1024);
    LAS float* ps = qs + 64;
    const int b = unit >> 5, j = (unit >> 3) & 3, t = unit & 7;
    const size_t row = (size_t)MP + 8 * b + t;
    const float* cK = a.in[3]; const float* cV = a.in[4];
    const float* nK = a.out + O_KS; const float* nV = a.out + O_VS;
    float og0 = 0.f, og1 = 0.f, og2 = 0.f, l0 = 0.f, l1 = 0.f, l2 = 0.f;
#pragma unroll 1
    for (int g = 0; g < 3; ++g) {
        const int dl = g == 0 ? 1 : (g == 1 ? 4 : 16);
        const int qh = g * 4 + j;
        const float x = bf2f(qraw[row * 768 + qh * 64 + lane]);
        const float ss = wave_sum(x * x);
        const float xn = x * rsqrtf(ss * (1.f / 64.f) + EPS) * qn[lane];
        const float xp = __shfl_xor(xn, 32);
        const int i = lane & 31;
        const float cs = rope[((2048 + t) * 32 + i) * 2], sn = rope[((2048 + t) * 32 + i) * 2 + 1];
        const float y = lane < 32 ? xn * cs - xp * sn : xp * sn + xn * cs;
        qs[lane] = y * 0.125f;
        asm volatile("s_waitcnt lgkmcnt(0)" ::: "memory");
        float mx = -INFINITY;
#pragma unroll 1
        for (int rr = 0; rr < 3; ++rr) {
            const int jj = 64 * rr + lane;
            float dot = -INFINITY;
            if (jj <= 128) {
                const int srow = 2048 + t - dl * jj;
                const float* kp = srow >= 2048 ? nK + ((size_t)(8 * b + srow - 2048) * 4 + j) * 64 : cK + (((size_t)b * 2048 + srow) * 4 + j) * 64;
                float acc = 0.f;
#pragma unroll
                for (int q = 0; q < 16; ++q) { const f32x4 kv = *(const f32x4*)(kp + 4 * q); const f32x4 qv = *(const LAS f32x4*)(qs + 4 * q); acc += kv[0] * qv[0] + kv[1] * qv[1] + kv[2] * qv[2] + kv[3] * qv[3]; }
                dot = acc;
            }
            ps[jj] = dot; mx = fmaxf(mx, dot);
            asm volatile("" ::: "memory");
        }
        mx = wave_max(mx);
        float ds = 0.f;
#pragma unroll 1
        for (int rr = 0; rr < 3; ++rr) { const int jj = 64 * rr + lane; const float pv = __expf(ps[jj] - mx); ps[jj] = pv; ds += pv; }
        const float den = wave_sum(ds);
        asm volatile("s_waitcnt lgkmcnt(0)" ::: "memory");
        float o = 0.f;
#pragma unroll 16
        for (int jj = 0; jj <= 128; ++jj) {
            const float pj = ps[jj];
            const int srow = 2048 + t - dl * jj;
            const float* vp = srow >= 2048 ? nV + ((size_t)(8 * b + srow - 2048) * 4 + j) * 64 : cV + (((size_t)b * 2048 + srow) * 4 + j) * 64;
            o += pj * vp[lane];
        }
        { const float ov = o / den, lv = mx + __logf(den); if (g == 0) { og0 = ov; l0 = lv; } else if (g == 1) { og1 = ov; l1 = lv; } else { og2 = ov; l2 = lv; } }
        asm volatile("s_waitcnt lgkmcnt(0)" ::: "memory");
    }
    const float lm = fmaxf(fmaxf(l0, l1), l2);
    const float e0 = __expf(l0 - lm), e1 = __expf(l1 - lm), e2 = __expf(l2 - lm), is = 1.f / (e0 + e1 + e2);
    AA[row * 768 + (0 + j) * 64 + lane] = f2bf(og0 * e0 * is);
    AA[row * 768 + (4 + j) * 64 + lane] = f2bf(og1 * e1 * is);
    AA[row * 768 + (8 + j) * 64 + lane] = f2bf(og2 * e2 * is);
}

DI void attn_phase(const Args& a, LAS unsigned char* lds, int tid, int lane, int wave) {
    unsigned char* ws = a.ws;
    const int G = gridDim.x, GP = G > 1 ? G / 2 : 1;
    if ((int)blockIdx.x < GP) {
        const float* OG = (const float*)(ws + WS_U2); const float* LSE = (const float*)(ws + WS_LSE);
        bf16* AA = (bf16*)(ws + WS_U1 + 32 * MiB);
        for (int u = blockIdx.x; u < 128; u += GP) {
            const int b = u >> 4, j = (u >> 2) & 3, sp = u & 3, T0 = 512 * sp;
            for (int jb = wave; jb < 48; jb += 8) {
                const int g = jb >> 4, q = jb & 15;
                const int dl = g == 0 ? 1 : (g == 1 ? 4 : 16), tpr = 16 / dl;
                const int res = q / tpr, a0 = T0 / dl + 32 * (q % tpr);
                attn_tile(a, b, j, g, res, a0, lane);
            }
            __builtin_amdgcn_fence(__ATOMIC_RELEASE, "agent");
            __syncthreads();
            __builtin_amdgcn_fence(__ATOMIC_ACQUIRE, "agent");
            {
                const size_t row = (size_t)b * SEQ + T0 + tid;
                const float l0 = LSE[row * 12 + j], l1 = LSE[row * 12 + 4 + j], l2 = LSE[row * 12 + 8 + j];
                const float lm = fmaxf(fmaxf(l0, l1), l2);
                const float e0 = __expf(l0 - lm), e1 = __expf(l1 - lm), e2 = __expf(l2 - lm), is = 1.f / (e0 + e1 + e2);
#pragma unroll
                for (int g = 0; g < 3; ++g) {
                    const float wg = (g == 0 ? e0 : (g == 1 ? e1 : e2)) * is;
                    const float* src = OG + row * 768 + (g * 4 + j) * 64; bf16* dst = AA + row * 768 + (g * 4 + j) * 64;
#pragma unroll
                    for (int i = 0; i < 8; ++i) { const f32x4 x0 = *(const f32x4*)(src + 8 * i), x1 = *(const f32x4*)(src + 8 * i + 4);
                        u32x4 o; o.x = cvtpk(x0[0] * wg, x0[1] * wg); o.y = cvtpk(x0[2] * wg, x0[3] * wg); o.z = cvtpk(x1[0] * wg, x1[1] * wg); o.w = cvtpk(x1[2] * wg, x1[3] * wg);
                        *(u32x4*)(dst + 8 * i) = o; }
                }
            }
            __syncthreads();
        }
    } else {
        const int nb = G - GP;
        for (int u = ((int)blockIdx.x - GP) * 8 + wave; u < 1024; u += nb * 8) attn_sample_unit(a, lds, u, lane, wave);
    }
}

#define XB_TMO      128
#define XB_XCNT(j)  (256  + 64 * (j))
#define XB_XSUB(j)  (1280 + 64 * (j))
#define XB_XGEN(j)  (2304 + 64 * (j))
#define XB_TOP      3328
#define XB_TOPGEN   3392
#define XCD_BAR_WORDS 3456
#define XB_SPIN_CAP (1u << 18)

__device__ __forceinline__ unsigned xb_ld(unsigned* p)              { return __hip_atomic_load(p, __ATOMIC_RELAXED, __HIP_MEMORY_SCOPE_AGENT); }
__device__ __forceinline__ unsigned xb_add(unsigned* p, unsigned v) { return __hip_atomic_fetch_add(p, v, __ATOMIC_RELAXED, __HIP_MEMORY_SCOPE_AGENT); }
__device__ __forceinline__ unsigned xb_xcc_id() { return (unsigned)__builtin_amdgcn_s_getreg((3 << 11) | 20) & 0xFu; }
#define XB_SPIN(cond, bar) do { unsigned _sp = 0; while (cond) { __builtin_amdgcn_s_sleep(1); \
    if ((++_sp & 255u) == 0u) { if (xb_ld(&(bar)[XB_TMO])) break; if (_sp > XB_SPIN_CAP) { atomicAdd(&(bar)[XB_TMO], 1u); break; } } } } while (0)

struct XcdBarrier {
    unsigned* bar; unsigned x;
    volatile LAS unsigned* st;
};

__device__ __forceinline__ XcdBarrier xcd_barrier_post(unsigned* bar, volatile LAS unsigned* st) {
    XcdBarrier b; b.bar = bar; b.x = xb_xcc_id(); b.st = st;
    if (threadIdx.x == 0) (void)xb_add(&bar[XB_XCNT(b.x)], 1u);
    return b;
}
__device__ __forceinline__ void xcd_barrier_complete(unsigned* bar, unsigned x, unsigned& nloc, unsigned& nx) {
    const unsigned G = gridDim.x * gridDim.y * gridDim.z;
    unsigned sum, cnt, mine, sp = 0u;
    for (;;) {
        sum = 0u; cnt = 0u; mine = 0u;
#pragma unroll
        for (unsigned j = 0; j < 16; ++j) { const unsigned c = xb_ld(&bar[XB_XCNT(j)]); sum += c; cnt += (c > 0u) ? 1u : 0u; mine = (j == x) ? c : mine; }
        if (sum == G) break;
        __builtin_amdgcn_s_sleep(1);
        if ((++sp & 255u) == 0u) { if (xb_ld(&bar[XB_TMO])) break; if (sp > XB_SPIN_CAP) { atomicAdd(&bar[XB_TMO], 1u); break; } }
    }
    nloc = mine > 0u ? mine : 1u; nx = cnt > 0u ? cnt : 1u;
}

__device__ __forceinline__ void xcd_barrier(const XcdBarrier& b) {
    asm volatile("s_waitcnt vmcnt(0)" ::: "memory");
    __syncthreads();
    if (threadIdx.x == 0) {
        unsigned* bar = b.bar;
        __builtin_amdgcn_s_waitcnt(0);
        unsigned nloc = b.st[0], nx = b.st[1];
        if (nloc == 0u) { xcd_barrier_complete(bar, b.x, nloc, nx); b.st[0] = nloc; b.st[1] = nx; }
        const unsigned old = xb_add(&bar[XB_XSUB(b.x)], 1u);
        const unsigned gen = old / nloc;
        if (old + 1u == (gen + 1u) * nloc) {
            __builtin_amdgcn_fence(__ATOMIC_RELEASE, "agent");
            asm volatile("s_waitcnt vmcnt(0)" ::: "memory");
            const unsigned og = xb_add(&bar[XB_TOP], 1u);
            const unsigned tg = og / nx;
            if (og + 1u == (tg + 1u) * nx) xb_add(&bar[XB_TOPGEN], 1u);
            else XB_SPIN(xb_ld(&bar[XB_TOPGEN]) == tg, bar);
            __builtin_amdgcn_fence(__ATOMIC_ACQUIRE, "agent");
            xb_add(&bar[XB_XGEN(b.x)], 1u);
            asm volatile("s_waitcnt vmcnt(0)" ::: "memory");
        } else {
            XB_SPIN(xb_ld(&bar[XB_XGEN(b.x)]) == gen, bar);
            __builtin_amdgcn_fence(__ATOMIC_ACQUIRE, "agent");
            asm volatile("s_waitcnt vmcnt(0)" ::: "memory");
        }
    }
    __syncthreads();
}

__global__ void __launch_bounds__(512, 2) mk_fwd(Args a) {
    extern __shared__ __attribute__((aligned(16))) unsigned char lds_raw[];
    LAS unsigned char* lds = (LAS unsigned char*)lds_raw;
    cg::grid_group grid = cg::this_grid();
    const int tid = threadIdx.x, lane = tid & 63, wave = __builtin_amdgcn_readfirstlane(tid >> 6);
    unsigned char* ws = a.ws;
    const int lo = a.ph_lo, hi = a.ph_hi, G = gridDim.x, bx = blockIdx.x;
    float* ssq = (float*)(ws + WS_SSQ);
    volatile LAS unsigned* bst = (volatile LAS unsigned*)(lds + LDS_BYTES - 64);
    if (tid < 2) bst[tid] = 0u;
    __syncthreads();
    const XcdBarrier xbar = xcd_barrier_post((unsigned*)(ws + WS_BAR), bst);
    bf16* XB = (bf16*)(ws + WS_XB);
    bf16* ACT = (bf16*)(ws + WS_U1);
#define IN(k) (lo <= (k) && (k) < hi)
#define SEAM(k) do { if (IN(k) && IN((k) + 1)) { if ((k) == 0) grid.sync(); else xcd_barrier(xbar); } } while (0)
#define GEMM(EpiT, E, Aptr, Bptr, N_, K_, cidx) do { pg8::Gemm g_{(const pg8::bf16_t*)(Aptr), (const pg8::bf16_t*)(Bptr), M, (N_), (K_)}; pg8::StaticOrder S_; S_.init(M, (N_), G, (cidx)); \
        pg8::gemm_phase<EpiT, pg8::StaticOrder, true, true>(lds, g_, S_, E); } while (0)
#define FFN_IN(mi, slot) do { EpiSwiGLU E_{ACT, ssq + (slot) * M}; GEMM(EpiSwiGLU, E_, XB, (bf16*)(ws + W_FI) + (size_t)(mi) * 2 * FF * D, 2 * FF, D, bx); } while (0)
#define FFN_OUT(mi, slot, last) do { EpiResid E_{a.out, (last) ? nullptr : XB, (last) ? nullptr : ssq + (slot) * M, 0.5f}; GEMM(EpiResid, E_, ACT, (bf16*)(ws + W_FO) + (size_t)(mi) * D * FF, D, FF, bx); } while (0)

    if (IN(0)) { p0_prologue(a, lds, tid, lane, wave); __syncthreads(); } SEAM(0);
    if (IN(1)) { FFN_IN(0, 0); } SEAM(1);
    if (IN(2)) { FFN_OUT(0, 1, false); } SEAM(2);
    if (IN(3)) { EpiScale E_{(bf16*)(ws + WS_U1), nullptr, NGLA, ssq + 1 * M}; GEMM(EpiScale, E_, XB, ws + W_GI, NGLA, D, bx); } SEAM(3);
    if (IN(4)) { gla_prep(a, lds, tid, lane, wave); } SEAM(4);
    if (IN(5)) { gla_rec(a, lds, tid, lane, wave); } SEAM(5);
    if (IN(6)) { EpiResid E_{a.out, XB, ssq + 2 * M, 1.0f}; GEMM(EpiResid, E_, ws + WS_U3, ws + W_GO, D, D, bx); } SEAM(6);
    if (IN(7)) { FFN_IN(1, 2); } SEAM(7);
    if (IN(8)) { FFN_OUT(1, 3, false); } SEAM(8);
    if (IN(9)) {
        { EpiScale E_{nullptr, (float*)(ws + WS_U2), 512, ssq + 3 * M}; GEMM(EpiScale, E_, XB, ws + W_KV, 512, D, bx); }
        { EpiSwiGLU E_{ACT, ssq + 3 * M}; GEMM(EpiSwiGLU, E_, XB, (bf16*)(ws + W_FI) + (size_t)2 * 2 * FF * D, 2 * FF, D, (G == 256) ? ((bx + 120) & 255) : bx); }
    } SEAM(9);
    if (IN(10)) {
        FFN_OUT(2, 4, false);
        if (G > 8) { if (bx >= 4) for (int it = bx - 4; it < M / 64; it += G - 4) kv_post_item(a, it, tid); }
        else for (int it = bx; it < M / 64; it += G) kv_post_item(a, it, tid);
    } SEAM(10);
    if (IN(11)) { EpiScale E_{(bf16*)(ws + WS_U1), nullptr, 768, ssq + 4 * M}; GEMM(EpiScale, E_, XB, ws + W_Q, 768, D, bx); } SEAM(11);
    if (IN(12)) { attn_phase(a, lds, tid, lane, wave); } SEAM(12);
    if (IN(13)) { EpiResid E_{a.out, XB, ssq + 5 * M, 1.0f}; GEMM(EpiResid, E_, ws + WS_U1 + 32 * MiB, ws + W_AO, D, 768, bx); } SEAM(13);
    if (IN(14)) { FFN_IN(3, 5); } SEAM(14);
    if (IN(15)) { FFN_OUT(3, 0, true); }
}

extern "C" void kernel_launch(void* const* d_in, const int* in_sizes, int n_in, void* d_out, int out_size, void* d_ws, size_t ws_size, hipStream_t stream) {
    static int grid = 0;
    if (grid == 0) {
        if (n_in != 19 || ws_size < WS_END) { fprintf(stderr, "kernel_launch: expected 19 inputs and >= %zu bytes of workspace (got %d, %zu)\n", (size_t)WS_END, n_in, ws_size); grid = -1; return; }
        int dev = 0, cus = 0, per_cu = 0;
        (void)hipGetDevice(&dev); (void)hipDeviceGetAttribute(&cus, hipDeviceAttributeMultiprocessorCount, dev);
        if (hipFuncSetAttribute((const void*)mk_fwd, hipFuncAttributeMaxDynamicSharedMemorySize, LDS_BYTES) != hipSuccess) { fprintf(stderr, "kernel_launch: hipFuncSetAttribute failed\n"); grid = -1; return; }
        if (hipOccupancyMaxActiveBlocksPerMultiprocessor(&per_cu, (const void*)mk_fwd, 512, LDS_BYTES) != hipSuccess || per_cu < 1) { fprintf(stderr, "kernel_launch: occupancy query failed (%d)\n", per_cu); per_cu = 1; }
        (void)hipGetLastError();
        grid = cus * (per_cu > 1 ? 1 : per_cu);
        if (grid <= 0) grid = 256;
    }
    if (grid < 0) return;
    (void)hipMemsetAsync((unsigned char*)d_ws + WS_BAR, 0, XCD_BAR_WORDS * 4, stream);
    Args a{};
    for (int i = 0; i < 19; ++i) a.in[i] = (const float*)d_in[i];
    a.out = (float*)d_out; a.ws = (unsigned char*)d_ws;
#if MK_PER_PHASE
    for (int p = 0; p < NPHASE; ++p) { a.ph_lo = p; a.ph_hi = p + 1; hipLaunchKernelGGL(mk_fwd, dim3(grid), dim3(512), LDS_BYTES, stream, a); }
#else
    a.ph_lo = 0; a.ph_hi = NPHASE;
    void* args[] = {&a};
    hipError_t e = hipLaunchCooperativeKernel((const void*)mk_fwd, dim3(grid), dim3(512), args, LDS_BYTES, stream);
    if (e != hipSuccess) fprintf(stderr, "kernel_launch: cooperative launch failed: %s (grid %d)\n", hipGetErrorString(e), grid);
#endif
}
```

```cpp
#include <hip/hip_runtime.h>
#include <hip/hip_cooperative_groups.h>
#include <cstdio>
#include <cstdint>
namespace cg = cooperative_groups;
namespace pg8 {
#define PG8_LAS __attribute__((address_space(3)))
typedef unsigned short bf16_t;
typedef short bf16x8 __attribute__((ext_vector_type(8)));
typedef float f32x4 __attribute__((ext_vector_type(4)));
typedef unsigned u32x4 __attribute__((ext_vector_type(4)));
constexpr int BM = 256, BK = 64, HALF = 128, HTB = HALF * BK * 2  , STAGE_BYTES = 8 * HTB, NXCD = 8, WGM = 8;

__host__ __device__ __forceinline__ int lds_byte(int r, int c) { const int st = (r >> 4) * 2 + (c >> 5), rr = r & 15, cc = c & 31, ob = rr * 64 + cc * 2; return st * 1024 + (ob ^ (((ob >> 9) & 1) << 5)); }
__host__ __device__ __forceinline__ void stage_rc(int b, int& R, int& C) { const int st = b / 1024, sb = b % 1024, swz = sb ^ (((sb >> 9) & 1) << 5); R = (st >> 1) * 16 + swz / 64; C = (st & 1) * 32 + (swz % 64) / 2; }
__host__ __device__ __forceinline__ int perm32(int rho) { const int n = rho >> 4, i = rho & 15; return 8 * (i >> 2) + 4 * n + (i & 3); }

struct Unit { int pm, pn, ko; };
struct Gemm { const bf16_t* A; const bf16_t* Bt; int M, N, K, ld; };

struct StaticOrder {
    int nM, nN, nwg, G, c;
    __host__ __device__ void init(int M, int N, int G_, int c_) { nM = M / BM; nN = N / BM; nwg = nM * nN; G = G_; c = c_; }
    __host__ __device__ bool next(int i, Unit& u) const {
        const long L = (long)i * G + c; if (L >= nwg) return false;
        int wgid = (int)L; { const int q = nwg / NXCD, r = nwg % NXCD, xcd = wgid % NXCD, off = wgid / NXCD; wgid = (xcd < r ? xcd * (q + 1) : r * (q + 1) + (xcd - r) * q) + off; }
        const int nig = WGM * nN, gid = wgid / nig, fm = gid * WGM, gsz = (nM - fm) < WGM ? (nM - fm) : WGM;
        u.pm = fm + ((wgid % nig) % gsz); u.pn = (wgid % nig) / gsz; u.ko = 0; return true;
    }
    __device__ __forceinline__ void a_ready(const Unit&) const {}
    __device__ __forceinline__ void done(const Unit&) const {}
};

__device__ __forceinline__ unsigned cvt_pk_bf16(float lo, float hi) { unsigned r; asm volatile("v_cvt_pk_bf16_f32 %0, %1, %2" : "=v"(r) : "v"(lo), "v"(hi)); return r; }
typedef float f32x2 __attribute__((ext_vector_type(2)));
__device__ __forceinline__ f32x2 gelu_pk(f32x2 v) {
    const f32x2 av = __builtin_elementwise_abs(v), d = av * 0.2316418882f + 1.0f;
    f32x2 t; t.x = __builtin_amdgcn_rcpf(d.x); t.y = __builtin_amdgcn_rcpf(d.y);
    f32x2 q = t * 0.5307027145f + (-0.7265760135f); q = q * t + 0.7107068705f; q = q * t + (-0.142248368f); q = q * t + 0.127414796f; q = q * t;
    const f32x2 s = (v * v) * (-0.72134752044f);
    f32x2 e; e.x = __builtin_amdgcn_exp2f(s.x); e.y = __builtin_amdgcn_exp2f(s.y);
    const f32x2 m = v * (q * e), r = v - m;
    f32x2 o; o.x = v.x < 0.f ? m.x : r.x; o.y = v.y < 0.f ? m.y : r.y; return o;
}

template <int ACT  > struct EpiBf16 {
    static constexpr bool PERM = true, AFTER_DRAIN = false; static_assert(ACT == 0 || ACT == 1, "EpiBf16: ACT is 0 (none) or 1 (gelu_pk)");
    bf16_t* O; int ldc; const float* bias; int split_cols; size_t split_stride; float scale0;
    __device__ __forceinline__ void operator()(const f32x4 (&acc)[2][2][4][2], const Unit& u, int wr, int wc, int fr, int fq) const {
        const int row0 = u.pm * BM + wr * 64 + fr; int colt = u.pn * BM; bf16_t* base = O;
        float sc = 1.f; if (split_cols) { const int t = colt / split_cols; base += (size_t)t * split_stride; colt -= t * split_cols; if (t == 0) sc = scale0; }
        const int col0 = colt + wc * 32 + 8 * fq, bcol0 = u.pn * BM + wc * 32 + 8 * fq;
        f32x4 bv[2][2];
#pragma unroll
        for (int bj = 0; bj < 2; ++bj)
#pragma unroll
            for (int n = 0; n < 2; ++n) bv[bj][n] = bias ? *(const f32x4*)(bias + bcol0 + bj * HALF + 4 * n) : (f32x4){0.f, 0.f, 0.f, 0.f};
#pragma unroll
        for (int ai = 0; ai < 2; ++ai)
#pragma unroll
            for (int m = 0; m < 4; ++m) { bf16_t* rowp = base + (size_t)(row0 + ai * HALF + m * 16) * ldc + col0;
#pragma unroll
                for (int bj = 0; bj < 2; ++bj) { f32x4 v0 = acc[ai][bj][m][0] + bv[bj][0], v1 = acc[ai][bj][m][1] + bv[bj][1];
                    if (ACT == 1) { f32x2 a = gelu_pk((f32x2){v0[0], v0[1]}), b = gelu_pk((f32x2){v0[2], v0[3]}), c = gelu_pk((f32x2){v1[0], v1[1]}), d = gelu_pk((f32x2){v1[2], v1[3]});
                        v0 = (f32x4){a.x, a.y, b.x, b.y}; v1 = (f32x4){c.x, c.y, d.x, d.y}; }
                    v0 = v0 * sc; v1 = v1 * sc; u32x4 w; w.x = cvt_pk_bf16(v0[0], v0[1]); w.y = cvt_pk_bf16(v0[2], v0[3]); w.z = cvt_pk_bf16(v1[0], v1[1]); w.w = cvt_pk_bf16(v1[2], v1[3]);
                    *(u32x4*)(rowp + bj * HALF) = w; } }
    }
};

struct PanelStats {
    unsigned* xbuf;
    unsigned* cnt;
    unsigned* tmo;
    int ntn; float eps;
    unsigned code;
    __device__ __forceinline__ bool run(const f32x4 (&v)[2][2][4][2], const Unit& u, int wr, int wc, int fr, int fq, PG8_LAS unsigned char* lds, int wid, int lane) const {
        typedef float f32x2v __attribute__((ext_vector_type(2)));
        PG8_LAS f32x2v* P = (PG8_LAS f32x2v*)lds;
        PG8_LAS f32x2v* S = (PG8_LAS f32x2v*)(lds + 8192);
        PG8_LAS unsigned* flag = (PG8_LAS unsigned*)(lds + 8192 + 2048);
#pragma unroll
        for (int ai = 0; ai < 2; ++ai)
#pragma unroll
            for (int m = 0; m < 4; ++m) {
                float s = 0.f;
#pragma unroll
                for (int bj = 0; bj < 2; ++bj)
#pragma unroll
                    for (int n = 0; n < 2; ++n) { const f32x4 x = v[ai][bj][m][n]; s += (x[0] + x[1]) + (x[2] + x[3]); }
                s += __shfl_xor(s, 16); s += __shfl_xor(s, 32);
                const float mw = s * (1.0f / 64.0f); float q = 0.f;
#pragma unroll
                for (int bj = 0; bj < 2; ++bj)
#pragma unroll
                    for (int n = 0; n < 2; ++n) { const f32x4 d = v[ai][bj][m][n] - mw; q += (d[0] * d[0] + d[1] * d[1]) + (d[2] * d[2] + d[3] * d[3]); }
                q += __shfl_xor(q, 16); q += __shfl_xor(q, 32);
                if (fq == 0) P[(ai * HALF + wr * 64 + m * 16 + fr) * 4 + wc] = (f32x2v){mw, q};
            }
        asm volatile("s_waitcnt lgkmcnt(0)" ::: "memory"); __builtin_amdgcn_s_barrier(); asm volatile("" ::: "memory");
#if defined(BROKEN_EXCHANGE_NO_WAIT)
#warning BROKEN CONTROL BUILD: the row-statistics exchange does not wait; results are wrong by design
        if (blockIdx.x >= 64) { const long long t0_ = clock64(); while (clock64() - t0_ < 60000) __builtin_amdgcn_s_sleep(8); }
#endif
        const int row = wid * 32 + (lane & 31);
        if (lane < 32) {
            const f32x2v a = P[row * 4 + 0], b = P[row * 4 + 1], c = P[row * 4 + 2], d = P[row * 4 + 3];
            const float mt = (a.x + b.x + c.x + d.x) * 0.25f;
            const float da = a.x - mt, db = b.x - mt, dc = c.x - mt, dd = d.x - mt;
            const float m2 = (a.y + b.y) + (c.y + d.y) + 64.0f * ((da * da + db * db) + (dc * dc + dd * dd));
            unsigned long long* slot = (unsigned long long*)xbuf + ((size_t)(u.pm * BM + row) * 4 + u.pn);
            __hip_atomic_store(slot, ((unsigned long long)__float_as_uint(m2) << 32) | __float_as_uint(mt), __ATOMIC_RELAXED, __HIP_MEMORY_SCOPE_AGENT);
        }
        asm volatile("s_waitcnt vmcnt(0)" ::: "memory");
        if (lane == 0) __hip_atomic_fetch_add(cnt + 64 * u.pm, 1u, __ATOMIC_RELAXED, __HIP_MEMORY_SCOPE_AGENT);
        if (wid == 0) {
            bool dead = false; const unsigned long long t0 = __builtin_amdgcn_s_memrealtime(); const unsigned want = 8u * (unsigned)ntn;
            for (;;) {
#if defined(BROKEN_EXCHANGE_NO_WAIT)
                break;
#endif
                if ((unsigned)__builtin_amdgcn_readfirstlane(__hip_atomic_load(cnt + 64 * u.pm, __ATOMIC_RELAXED, __HIP_MEMORY_SCOPE_AGENT)) >= want) break;
                if (__builtin_amdgcn_s_memrealtime() - t0 > 2000000ull) {
                    if (lane == 0) { unsigned expect = 0u; __hip_atomic_compare_exchange_strong(tmo + 1, &expect, code | (unsigned)(u.pm & 0xff), __ATOMIC_RELAXED, __ATOMIC_RELAXED, __HIP_MEMORY_SCOPE_AGENT);
                                     __hip_atomic_store(tmo, 1u, __ATOMIC_RELAXED, __HIP_MEMORY_SCOPE_AGENT); }
                    dead = true; break; }
                __builtin_amdgcn_s_sleep(2);
            }
            __builtin_amdgcn_fence(__ATOMIC_ACQUIRE, "agent");
            if (lane == 0) flag[0] = dead ? 1u : 0u;
        }
        asm volatile("s_waitcnt vmcnt(0) lgkmcnt(0)" ::: "memory"); __builtin_amdgcn_s_barrier(); asm volatile("" ::: "memory");
        const bool bad = flag[0] != 0u;
        if (lane < 32) {
            const unsigned long long* slot = (const unsigned long long*)xbuf + (size_t)(u.pm * BM + row) * 4; float mt[4], m2[4]; float ms = 0.f;
#pragma unroll
            for (int t = 0; t < 4; ++t) { if (t < ntn) { const unsigned long long w = __hip_atomic_load(slot + t, __ATOMIC_RELAXED, __HIP_MEMORY_SCOPE_AGENT); mt[t] = __uint_as_float((unsigned)w); m2[t] = __uint_as_float((unsigned)(w >> 32)); } else { mt[t] = 0.f; m2[t] = 0.f; } ms += mt[t]; }
            const float mean = ms / (float)ntn; float q = 0.f;
#pragma unroll
            for (int t = 0; t < 4; ++t) if (t < ntn) { const float dm = mt[t] - mean; q += m2[t] + 256.0f * dm * dm; }
            S[row] = (f32x2v){mean, 1.0f / sqrtf(q / (256.0f * (float)ntn) + eps)};
        }
        asm volatile("s_waitcnt lgkmcnt(0)" ::: "memory"); __builtin_amdgcn_s_barrier(); asm volatile("" ::: "memory");
        return bad;
    }
};
struct EpiLnRes {
    static constexpr bool PERM = false, AFTER_DRAIN = true;
    const float* base; float* out; int ldc; const float* bias; PanelStats st; unsigned poison;
    __device__ __forceinline__ void fused(f32x4 (&acc)[2][2][4][2], const Unit& u, int wr, int wc, int fr, int fq, PG8_LAS unsigned char* lds, int wid, int lane) const {
        typedef float f32x2v __attribute__((ext_vector_type(2)));
        const PG8_LAS f32x2v* S = (const PG8_LAS f32x2v*)(lds + 8192);
        const int col0 = u.pn * BM + wc * 32 + 4 * fq;
#pragma unroll
        for (int bj = 0; bj < 2; ++bj)
#pragma unroll
            for (int n = 0; n < 2; ++n) { const f32x4 bv = bias ? *(const f32x4*)(bias + col0 + bj * HALF + n * 16) : (f32x4){0.f, 0.f, 0.f, 0.f};
#pragma unroll
                for (int ai = 0; ai < 2; ++ai)
#pragma unroll
                    for (int m = 0; m < 4; ++m) acc[ai][bj][m][n] += bv; }
        f32x4 pre[4][2][2];
#pragma unroll
        for (int m = 0; m < 4; ++m) { const size_t off = (size_t)(u.pm * BM + wr * 64 + m * 16 + fr) * ldc + col0;
#pragma unroll
            for (int bj = 0; bj < 2; ++bj)
#pragma unroll
                for (int n = 0; n < 2; ++n) pre[m][bj][n] = *(const f32x4*)(base + off + bj * HALF + n * 16); }
        const bool bad = st.run(acc, u, wr, wc, fr, fq, lds, wid, lane) || poison != 0u;
        const float qnan = __builtin_nanf("");
#pragma unroll
        for (int ai = 0; ai < 2; ++ai)
#pragma unroll
            for (int m = 0; m < 4; ++m) { const int r = ai * HALF + wr * 64 + m * 16 + fr; const f32x2v sr = S[r]; const size_t off = (size_t)(u.pm * BM + r) * ldc + col0;
#pragma unroll
                for (int bj = 0; bj < 2; ++bj)
#pragma unroll
                    for (int n = 0; n < 2; ++n) { const f32x4 bs = ai == 0 ? pre[m][bj][n] : *(const f32x4*)(base + off + bj * HALF + n * 16); f32x4 o = bs + (acc[ai][bj][m][n] - sr.x) * sr.y;
                        if (bad) o = (f32x4){qnan, qnan, qnan, qnan}; *(f32x4*)(out + off + bj * HALF + n * 16) = o; }
                if (m & 1) asm volatile("" ::: "memory"); }
    }
};
struct EpiLnResLn {
    static constexpr bool PERM = false, AFTER_DRAIN = true;
    const float* base; float* out; bf16_t* xn; int ldc; const float* bias; PanelStats st1, st2; unsigned poison;
    __device__ __forceinline__ void fused(f32x4 (&acc)[2][2][4][2], const Unit& u, int wr, int wc, int fr, int fq, PG8_LAS unsigned char* lds, int wid, int lane) const {
        typedef float f32x2v __attribute__((ext_vector_type(2))); typedef unsigned u32x2v __attribute__((ext_vector_type(2)));
        const PG8_LAS f32x2v* S = (const PG8_LAS f32x2v*)(lds + 8192);
        const int col0 = u.pn * BM + wc * 32 + 4 * fq;
#pragma unroll
        for (int bj = 0; bj < 2; ++bj)
#pragma unroll
            for (int n = 0; n < 2; ++n) { const f32x4 bv = bias ? *(const f32x4*)(bias + col0 + bj * HALF + n * 16) : (f32x4){0.f, 0.f, 0.f, 0.f};
#pragma unroll
                for (int ai = 0; ai < 2; ++ai)
#pragma unroll
                    for (int m = 0; m < 4; ++m) acc[ai][bj][m][n] += bv; }
        bool bad = st1.run(acc, u, wr, wc, fr, fq, lds, wid, lane) || poison != 0u;
        const float qnan = __builtin_nanf("");
#pragma unroll
        for (int ai = 0; ai < 2; ++ai)
#pragma unroll
            for (int m = 0; m < 4; ++m) { const int r = ai * HALF + wr * 64 + m * 16 + fr; const f32x2v sr = S[r]; const size_t off = (size_t)(u.pm * BM + r) * ldc + col0;
#pragma unroll
                for (int bj = 0; bj < 2; ++bj)
#pragma unroll
                    for (int n = 0; n < 2; ++n) { const f32x4 bs = *(const f32x4*)(base + off + bj * HALF + n * 16); acc[ai][bj][m][n] = bs + (acc[ai][bj][m][n] - sr.x) * sr.y; }
                asm volatile("" : "+v"(acc[ai][0][m][0]), "+v"(acc[ai][0][m][1]), "+v"(acc[ai][1][m][0]), "+v"(acc[ai][1][m][1]));
                if (m & 1) asm volatile("" ::: "memory"); }
        const bool bad1 = bad;
        bad = st2.run(acc, u, wr, wc, fr, fq, lds, wid, lane) || bad;
#pragma unroll
        for (int ai = 0; ai < 2; ++ai)
#pragma unroll
            for (int m = 0; m < 4; ++m) { const int r = ai * HALF + wr * 64 + m * 16 + fr; const f32x2v sr = S[r]; const size_t off = (size_t)(u.pm * BM + r) * ldc + col0;
#pragma unroll
                for (int bj = 0; bj < 2; ++bj)
#pragma unroll
                    for (int n = 0; n < 2; ++n) { const f32x4 x1 = acc[ai][bj][m][n]; *(f32x4*)(out + off + bj * HALF + n * 16) = bad1 ? (f32x4){qnan, qnan, qnan, qnan} : x1;
                        const f32x4 o = (x1 - sr.x) * sr.y; u32x2v w; w.x = cvt_pk_bf16(o[0], o[1]); w.y = cvt_pk_bf16(o[2], o[3]);
                        if (bad) { w.x = 0x7fc07fc0u; w.y = 0x7fc07fc0u; } *(u32x2v*)(xn + off + bj * HALF + n * 16) = w; }
                asm volatile("" ::: "memory"); }
    }
};

template <class Epi, class Sched, bool ALIGN_EPI = false, bool SP2 = false>
__device__ __forceinline__ void gemm_phase(PG8_LAS unsigned char* lds, const Gemm g, const Sched& S, const Epi& E) {
    const int tid = threadIdx.x, wid = __builtin_amdgcn_readfirstlane(tid >> 6), lane = tid & 63, wr = wid >> 2, wc = wid & 3, fr = lane & 15, fq = lane >> 4;
    const int K = g.ld, nt = g.K / BK;
    unsigned voffA[2], voffB[2];
#pragma unroll
    for (int i = 0; i < 2; ++i) { int R, C; stage_rc(tid * 16 + i * 8192, R, C); const int Rb = Epi::PERM ? ((R & ~31) + perm32(R & 31)) : R;
        voffA[i] = (unsigned)(R * K + C) * 2u; voffB[i] = (unsigned)(Rb * K + C) * 2u; }
    const size_t kstep = (size_t)(BK * 2);
    const size_t hstep = (size_t)HALF * K * 2;
    const size_t tstep = 2 * hstep;
    const unsigned ldsw = (unsigned)wid * 1024u;
    const int aoff = lds_byte(wr * 64 + fr, fq * 8), boff = lds_byte(wc * 32 + fr, fq * 8);
#define PG8_SA(b, h) (((b) * 2 + (h)) * HTB)
#define PG8_SB(b, h) ((4 + (b) * 2 + (h)) * HTB)
#define PG8_STAGE(bufoff, gbase, voff) do { _Pragma("unroll") for (int _i = 0; _i < 2; ++_i) \
        __builtin_amdgcn_global_load_lds((const unsigned*)((const char*)(gbase) + (voff)[_i]), (PG8_LAS unsigned*)(lds + (bufoff) + ldsw + _i * 8192), 16, 0, 0); } while (0)
#define PG8_LDA(dst, b, h) do { _Pragma("unroll") for (int m = 0; m < 4; ++m) _Pragma("unroll") for (int k = 0; k < 2; ++k) dst[m][k] = *(const PG8_LAS bf16x8*)(lds + PG8_SA(b, h) + aoff + m * 2048 + k * 1024); } while (0)
#define PG8_LDB(dst, b, h) do { _Pragma("unroll") for (int n = 0; n < 2; ++n) _Pragma("unroll") for (int k = 0; k < 2; ++k) dst[n][k] = *(const PG8_LAS bf16x8*)(lds + PG8_SB(b, h) + boff + n * 2048 + k * 1024); } while (0)
#define PG8_MMA(ai, bj, At, Bt) do { __builtin_amdgcn_s_setprio(1); _Pragma("unroll") for (int m = 0; m < 4; ++m) _Pragma("unroll") for (int n = 0; n < 2; ++n) _Pragma("unroll") for (int k = 0; k < 2; ++k) \
        acc[ai][bj][m][n] = __builtin_amdgcn_mfma_f32_16x16x32_bf16(Bt[n][k], At[m][k], acc[ai][bj][m][n], 0, 0, 0); __builtin_amdgcn_s_setprio(0); } while (0)
#define PG8_WAIT_V(n) asm volatile("s_waitcnt vmcnt(" #n ")" ::: "memory")
#define PG8_WAIT_L(n) asm volatile("s_waitcnt lgkmcnt(" #n ")" ::: "memory")
#define PG8_BAR __builtin_amdgcn_s_barrier()
#define PG8_SCHED __builtin_amdgcn_sched_barrier(0)
    Unit cur, nxt; int ui = 0;
    if (!S.next(0, cur)) return;
    f32x4 acc[2][2][4][2];
#pragma unroll
    for (int a = 0; a < 2; ++a)
#pragma unroll
        for (int b = 0; b < 2; ++b)
#pragma unroll
            for (int m = 0; m < 4; ++m)
#pragma unroll
                for (int n = 0; n < 2; ++n) acc[a][b][m][n] = (f32x4){0.f, 0.f, 0.f, 0.f};
    bf16x8 At[4][2], B0[2][2], B1[2][2];
    const char* cA = (const char*)g.A + (size_t)cur.pm * tstep + (size_t)cur.ko * 2; const char* cB = (const char*)g.Bt + (size_t)cur.pn * tstep + (size_t)cur.ko * 2;
    S.a_ready(cur);
    if constexpr (SP2) {
        PG8_STAGE(PG8_SB(0, 0), cB, voffB); PG8_STAGE(PG8_SB(0, 1), cB + hstep, voffB); PG8_STAGE(PG8_SA(0, 0), cA, voffA); PG8_STAGE(PG8_SA(0, 1), cA + hstep, voffA);
        if (wr == 1) PG8_BAR;
        PG8_WAIT_V(2); PG8_BAR;
        PG8_STAGE(PG8_SB(1, 0), cB + kstep, voffB); PG8_STAGE(PG8_SA(1, 0), cA + kstep, voffA); PG8_STAGE(PG8_SB(1, 1), cB + hstep + kstep, voffB);
        PG8_WAIT_V(6); PG8_BAR;
    } else {
        PG8_STAGE(PG8_SB(0, 0), cB, voffB); PG8_STAGE(PG8_SA(0, 0), cA, voffA); PG8_STAGE(PG8_SB(0, 1), cB + hstep, voffB); PG8_STAGE(PG8_SA(0, 1), cA + hstep, voffA);
        if (wr == 1) PG8_BAR;
        PG8_WAIT_V(4); PG8_BAR;
        PG8_STAGE(PG8_SB(1, 0), cB + kstep, voffB); PG8_STAGE(PG8_SA(1, 0), cA + kstep, voffA); PG8_STAGE(PG8_SB(1, 1), cB + hstep + kstep, voffB);
        PG8_WAIT_V(6); PG8_BAR;
    }
    for (;;) {
        const bool has_next = S.next(ui + 1, nxt);
        const char* nA = has_next ? (const char*)g.A + (size_t)nxt.pm * tstep + (size_t)nxt.ko * 2 : cA; const char* nB = has_next ? (const char*)g.Bt + (size_t)nxt.pn * tstep + (size_t)nxt.ko * 2 : cB;
        for (int t = 0; t < nt; t += 2) {
            const bool last = (t == nt - 2);
            const char* a1 = cA + (size_t)(t + 1) * kstep;
            const char* a2 = last ? nA : cA + (size_t)(t + 2) * kstep; const char* b2 = last ? nB : cB + (size_t)(t + 2) * kstep;
            const char* a3 = a2 + kstep; const char* b3 = b2 + kstep;
            if (last && has_next) S.a_ready(nxt);
            if constexpr (SP2) {
            PG8_LDB(B0, 0, 0); PG8_LDB(B1, 0, 1); PG8_SCHED; PG8_LDA(At, 0, 0); PG8_STAGE(PG8_SA(1, 1), a1 + hstep, voffA);
            PG8_WAIT_V(8); PG8_WAIT_L(0); PG8_BAR; PG8_MMA(0, 0, At, B0); PG8_MMA(0, 1, At, B1); PG8_BAR; PG8_SCHED;
            PG8_LDA(At, 0, 1); PG8_STAGE(PG8_SB(0, 0), b2, voffB); PG8_STAGE(PG8_SB(0, 1), b2 + hstep, voffB); PG8_STAGE(PG8_SA(0, 0), a2, voffA);
            PG8_WAIT_V(8); PG8_WAIT_L(0); PG8_BAR; PG8_MMA(1, 0, At, B0); PG8_MMA(1, 1, At, B1); PG8_BAR; PG8_SCHED;
            PG8_LDB(B0, 1, 0); PG8_LDB(B1, 1, 1); PG8_SCHED; PG8_LDA(At, 1, 0); PG8_STAGE(PG8_SA(0, 1), a2 + hstep, voffA);
            PG8_WAIT_V(8); PG8_WAIT_L(0); PG8_BAR; PG8_MMA(0, 0, At, B0); PG8_MMA(0, 1, At, B1); PG8_BAR; PG8_SCHED;
            PG8_LDA(At, 1, 1); PG8_STAGE(PG8_SB(1, 0), b3, voffB); PG8_STAGE(PG8_SB(1, 1), b3 + hstep, voffB); PG8_STAGE(PG8_SA(1, 0), a3, voffA);
            PG8_WAIT_V(8); PG8_WAIT_L(0); PG8_BAR; PG8_MMA(1, 0, At, B0); PG8_MMA(1, 1, At, B1); PG8_BAR; PG8_SCHED;
            } else {
            PG8_LDB(B0, 0, 0); PG8_SCHED; PG8_LDA(At, 0, 0); PG8_STAGE(PG8_SA(1, 1), a1 + hstep, voffA);
            PG8_WAIT_L(8); PG8_BAR; PG8_WAIT_L(0); PG8_MMA(0, 0, At, B0); PG8_BAR; PG8_SCHED;
            PG8_LDB(B1, 0, 1); PG8_STAGE(PG8_SB(0, 0), b2, voffB);
            PG8_BAR; PG8_WAIT_L(0); PG8_MMA(0, 1, At, B1); PG8_BAR;
            PG8_LDA(At, 0, 1); PG8_STAGE(PG8_SA(0, 0), a2, voffA);
            PG8_BAR; PG8_WAIT_L(0); PG8_MMA(1, 0, At, B0); PG8_BAR; PG8_SCHED;
            PG8_STAGE(PG8_SB(0, 1), b2 + hstep, voffB);
            PG8_WAIT_V(6); PG8_BAR; PG8_MMA(1, 1, At, B1); PG8_BAR;
            PG8_LDB(B0, 1, 0); PG8_SCHED; PG8_LDA(At, 1, 0); PG8_STAGE(PG8_SA(0, 1), a2 + hstep, voffA);
            PG8_WAIT_L(8); PG8_BAR; PG8_WAIT_L(0); PG8_MMA(0, 0, At, B0); PG8_BAR; PG8_SCHED;
            PG8_LDB(B1, 1, 1); PG8_STAGE(PG8_SB(1, 0), b3, voffB);
            PG8_BAR; PG8_WAIT_L(0); PG8_MMA(0, 1, At, B1); PG8_BAR;
            PG8_LDA(At, 1, 1); PG8_STAGE(PG8_SA(1, 0), a3, voffA);
            PG8_BAR; PG8_WAIT_L(0); PG8_MMA(1, 0, At, B0); PG8_BAR; PG8_SCHED;
            PG8_STAGE(PG8_SB(1, 1), b3 + hstep, voffB);
            PG8_WAIT_V(6); PG8_BAR; PG8_MMA(1, 1, At, B1); PG8_BAR;
            }
        }
        if constexpr (ALIGN_EPI) { if (wr == 0) PG8_BAR; }
        if constexpr (!Epi::AFTER_DRAIN) { E(acc, cur, wr, wc, fr, fq); S.done(cur); }
        if (!has_next) break;
#pragma unroll
        for (int a = 0; a < 2; ++a)
#pragma unroll
            for (int b = 0; b < 2; ++b)
#pragma unroll
                for (int m = 0; m < 4; ++m)
#pragma unroll
                    for (int n = 0; n < 2; ++n) acc[a][b][m][n] = (f32x4){0.f, 0.f, 0.f, 0.f};
        cur = nxt; cA = nA; cB = nB; ++ui;
        if constexpr (ALIGN_EPI) { if (wr == 1) PG8_BAR; }
    }
    PG8_WAIT_V(0);
    if constexpr (!ALIGN_EPI) { if (wr == 0) PG8_BAR; }
    PG8_BAR;
    if constexpr (Epi::AFTER_DRAIN) { E.fused(acc, cur, wr, wc, fr, fq, lds, wid, lane); S.done(cur); }
#undef PG8_SA
#undef PG8_SB
#undef PG8_STAGE
#undef PG8_LDA
#undef PG8_LDB
#undef PG8_MMA
#undef PG8_WAIT_V
#undef PG8_WAIT_L
#undef PG8_BAR
#undef PG8_SCHED
}
}

#define DI __device__ __forceinline__
#define LAS __attribute__((address_space(3)))
typedef unsigned short bf16;
typedef pg8::f32x4 f32x4;
typedef pg8::bf16x8 bf16x8;
typedef pg8::u32x4 u32x4;
typedef float f32x16 __attribute__((ext_vector_type(16)));
typedef float f32x2_t __attribute__((ext_vector_type(2)));
typedef __bf16 bf16x2_t __attribute__((ext_vector_type(2)));
typedef unsigned u32x2 __attribute__((ext_vector_type(2)));
#define MFMA32(a, b, c) __builtin_amdgcn_mfma_f32_32x32x16_bf16((a), (b), (c), 0, 0, 0)

#ifndef MK_PER_PHASE
#define MK_PER_PHASE 0
#endif

constexpr int MP = 16384, MS = 256, M = MP + MS, D = 1024, FF = 2688, NGLA = 3072, NCH = 288, SEQ = 2048;
constexpr float EPS = 1e-6f;
constexpr int NPHASE = 16;
constexpr size_t MiB = 1u << 20;
constexpr size_t WS_SSQ = 0;
constexpr size_t WS_BAR = 1 * MiB;
constexpr size_t W_FI = 2 * MiB;
constexpr size_t W_FO = W_FI + 42 * MiB;
constexpr size_t W_GI = W_FO + 21 * MiB;
constexpr size_t W_GO = W_GI + 6 * MiB;
constexpr size_t W_KV = W_GO + 2 * MiB;
constexpr size_t W_Q = W_KV + 1 * MiB;
constexpr size_t W_AO = W_Q + 1536 * 1024;
constexpr size_t W_GLR = W_AO + 1536 * 1024;
constexpr size_t W_ROPE = W_GLR + 65536;
constexpr size_t WS_XB = 78 * MiB;
constexpr size_t WS_U1 = 111 * MiB;
constexpr size_t WS_U2 = 209 * MiB;
constexpr size_t WS_U3 = 299 * MiB;
constexpr size_t WS_LSE = 332 * MiB;
constexpr size_t WS_END = 333 * MiB;
static_assert(W_ROPE + 2056 * 32 * 8 <= WS_XB, "ws map");
constexpr size_t O_Y = 0, O_SP = (size_t)M * D, O_SS = O_SP + 1048576, O_KP = O_SS + 4194304, O_VP = O_KP + 4194304, O_KS = O_VP + 4194304, O_VS = O_KS + 65536;

constexpr int LDS_BYTES = 147456;

struct Args { const float* in[19]; float* out; unsigned char* ws; int ph_lo, ph_hi; };

DI float bf2f(bf16 b) { return __uint_as_float((unsigned)b << 16); }
DI unsigned cvtpk(float lo, float hi) { f32x2_t v = {lo, hi}; bf16x2_t b = __builtin_convertvector(v, bf16x2_t); return __builtin_bit_cast(unsigned, b); }
DI bf16 f2bf(float f) { return (bf16)(cvtpk(f, 0.f) & 0xffffu); }
DI float wave_sum(float v) {
#pragma unroll
    for (int o = 1; o < 64; o <<= 1) v += __shfl_xor(v, o);
    return v;
}
DI float wave_max(float v) {
#pragma unroll
    for (int o = 1; o < 64; o <<= 1) v = fmaxf(v, __shfl_xor(v, o));
    return v;
}
DI int swz(int x) { return (x & ~12) | ((x & 4) << 1) | ((x & 8) >> 1); }
DI int crow(int reg, int h) { return (reg & 3) + 8 * (reg >> 2) + 4 * h; }
template <int S> DI bf16x8 pack8(const f32x16& x) {
    u32x4 p; p.x = cvtpk(x[8 * S], x[8 * S + 1]); p.y = cvtpk(x[8 * S + 2], x[8 * S + 3]); p.z = cvtpk(x[8 * S + 4], x[8 * S + 5]); p.w = cvtpk(x[8 * S + 6], x[8 * S + 7]);
    return __builtin_bit_cast(bf16x8, p);
}
DI float silu(float x) { return x / (1.f + __expf(-x)); }

struct EpiSwiGLU {
    static constexpr bool PERM = false, AFTER_DRAIN = false;
    bf16* O; const float* ssq;
    DI void operator()(const f32x4 (&acc)[2][2][4][2], const pg8::Unit& u, int wr, int wc, int fr, int fq) const {
        float rs[2][4];
#pragma unroll
        for (int ai = 0; ai < 2; ++ai)
#pragma unroll
            for (int m = 0; m < 4; ++m) rs[ai][m] = ssq[u.pm * 256 + ai * 128 + wr * 64 + m * 16 + fr];
        asm volatile("" ::: "memory");
#pragma unroll
        for (int ai = 0; ai < 2; ++ai)
#pragma unroll
            for (int m = 0; m < 4; ++m) {
                const int row = u.pm * 256 + ai * 128 + wr * 64 + m * 16 + fr;
                const float rstd = rsqrtf(rs[ai][m] * (1.f / D) + EPS);
#pragma unroll
                for (int bj = 0; bj < 2; ++bj) {
                    const f32x4 g = acc[ai][bj][m][0] * rstd, uu = acc[ai][bj][m][1] * rstd;
                    u32x2 w; w.x = cvtpk(silu(g[0]) * uu[0], silu(g[1]) * uu[1]); w.y = cvtpk(silu(g[2]) * uu[2], silu(g[3]) * uu[3]);
                    *(u32x2*)(O + (size_t)row * FF + u.pn * 128 + bj * 64 + wc * 16 + fq * 4) = w;
                }
            }
    }
};
struct EpiResid {
    static constexpr bool PERM = false, AFTER_DRAIN = false;
    float* X; bf16* XB; float* ssq_out; float scale;
    DI void operator()(const f32x4 (&acc)[2][2][4][2], const pg8::Unit& u, int wr, int wc, int fr, int fq) const {
#pragma unroll
        for (int ai = 0; ai < 2; ++ai) {
            f32x4 xv[4][2][2];
#pragma unroll
            for (int m = 0; m < 4; ++m)
#pragma unroll
                for (int bj = 0; bj < 2; ++bj)
#pragma unroll
                    for (int n = 0; n < 2; ++n)
                        xv[m][bj][n] = *(const f32x4*)(X + (size_t)(u.pm * 256 + ai * 128 + wr * 64 + m * 16 + fr) * D + u.pn * 256 + bj * 128 + wc * 32 + n * 16 + fq * 4);
            asm volatile("" ::: "memory");
#pragma unroll
            for (int m = 0; m < 4; ++m) {
                const int row = u.pm * 256 + ai * 128 + wr * 64 + m * 16 + fr;
                float ss = 0.f;
#pragma unroll
                for (int bj = 0; bj < 2; ++bj)
#pragma unroll
                    for (int n = 0; n < 2; ++n) {
                        const size_t off = (size_t)row * D + u.pn * 256 + bj * 128 + wc * 32 + n * 16 + fq * 4;
                        const f32x4 v = xv[m][bj][n] + acc[ai][bj][m][n] * scale;
                        *(f32x4*)(X + off) = v;
                        ss += (v[0] * v[0] + v[1] * v[1]) + (v[2] * v[2] + v[3] * v[3]);
                        if (XB) { u32x2 w; w.x = cvtpk(v[0], v[1]); w.y = cvtpk(v[2], v[3]); *(u32x2*)(XB + off) = w; }
                    }
                if (ssq_out) { ss += __shfl_xor(ss, 16); ss += __shfl_xor(ss, 32); if (fq == 0) atomicAdd(ssq_out + row, ss); }
            }
            asm volatile("" ::: "memory");
        }
    }
};
struct EpiScale {
    static constexpr bool PERM = false, AFTER_DRAIN = false;
    bf16* Ob; float* Of; int ldc; const float* ssq;
    DI void operator()(const f32x4 (&acc)[2][2][4][2], const pg8::Unit& u, int wr, int wc, int fr, int fq) const {
        float rs[2][4];
#pragma unroll
        for (int ai = 0; ai < 2; ++ai)
#pragma unroll
            for (int m = 0; m < 4; ++m) rs[ai][m] = ssq[u.pm * 256 + ai * 128 + wr * 64 + m * 16 + fr];
        asm volatile("" ::: "memory");
#pragma unroll
        for (int ai = 0; ai < 2; ++ai)
#pragma unroll
            for (int m = 0; m < 4; ++m) {
                const int row = u.pm * 256 + ai * 128 + wr * 64 + m * 16 + fr;
                const float rstd = rsqrtf(rs[ai][m] * (1.f / D) + EPS);
#pragma unroll
                for (int bj = 0; bj < 2; ++bj)
#pragma unroll
                    for (int n = 0; n < 2; ++n) {
                        const size_t off = (size_t)row * ldc + u.pn * 256 + bj * 128 + wc * 32 + n * 16 + fq * 4;
                        const f32x4 v = acc[ai][bj][m][n] * rstd;
                        if (Ob) { u32x2 w; w.x = cvtpk(v[0], v[1]); w.y = cvtpk(v[2], v[3]); *(u32x2*)(Ob + off) = w; }
                        else *(f32x4*)(Of + off) = v;
                    }
            }
    }
};

struct EpiPartial {
    static constexpr bool PERM = false, AFTER_DRAIN = false;
    float* P; int ks;
    DI void operator()(const f32x4 (&acc)[2][2][4][2], const pg8::Unit& u, int wr, int wc, int fr, int fq) const {
        float* base = P + (size_t)(u.ko / ks) * 256 * D;
#pragma unroll
        for (int ai = 0; ai < 2; ++ai)
#pragma unroll
            for (int m = 0; m < 4; ++m) {
                const int row = ai * 128 + wr * 64 + m * 16 + fr;
#pragma unroll
                for (int bj = 0; bj < 2; ++bj)
#pragma unroll
                    for (int n = 0; n < 2; ++n) *(f32x4*)(base + (size_t)row * D + u.pn * 256 + bj * 128 + wc * 32 + n * 16 + fq * 4) = acc[ai][bj][m][n];
            }
    }
};
struct SplitOrder {
    int ns, ks, c;
    __device__ bool next(int i, pg8::Unit& u) const { if (i != 0 || c >= 4 * ns) return false; u.pm = MP / 256; u.pn = c & 3; u.ko = (c >> 2) * ks; return true; }
    DI void a_ready(const pg8::Unit&) const {}
    DI void done(const pg8::Unit&) const {}
};

template <int MODE> DI int src_col(int n) {
    if (MODE == 1) { const int G = n >> 5, w = n & 31; return w < 16 ? G * 16 + w : FF + G * 16 + (w - 16); }
    if (MODE == 2) return n < 2048 ? n : n + 16;
    return n;
}
template <int MODE> DI void transpose_item(const float* W, int K, int ldw, int Ndst, bf16* WT, const float* gain, LAS float* scr, int item, int lane) {
    const int nblk = Ndst / 32, kb = item / nblk, nb = item % nblk, k0 = 64 * kb, n0 = 32 * nb;
    const int sc = src_col<MODE>(n0 + (lane & 31));
#pragma unroll 8
    for (int i = 0; i < 32; ++i) { const int kk = 2 * i + (lane >> 5); const float g = gain ? gain[k0 + kk] : 1.f; scr[kk * 33 + (lane & 31)] = W[(size_t)(k0 + kk) * ldw + sc] * g; }
    asm volatile("s_waitcnt lgkmcnt(0)" ::: "memory");
    const int c = lane & 7;
#pragma unroll
    for (int j = 0; j < 4; ++j) { const int n = (lane >> 3) + 8 * j; const LAS float* s = scr + (8 * c) * 33 + n;
        u32x4 o; o.x = cvtpk(s[0 * 33], s[1 * 33]); o.y = cvtpk(s[2 * 33], s[3 * 33]); o.z = cvtpk(s[4 * 33], s[5 * 33]); o.w = cvtpk(s[6 * 33], s[7 * 33]);
        *(u32x4*)(WT + (size_t)(n0 + n) * K + k0 + 8 * c) = o; }
    asm volatile("s_waitcnt lgkmcnt(0)" ::: "memory");
}

DI void p0_prologue(const Args& a, LAS unsigned char* lds, int tid, int lane, int wave) {
    unsigned char* ws = a.ws;
    LAS float* scr = (LAS float*)(lds + wave * 16384);
    const int G = gridDim.x, gw = blockIdx.x * 8 + wave, NGW = G * 8;
    const float* gains = a.in[5];
    constexpr int I_FI = 16 * 168, I_FO = 42 * 32, I_GI = 16 * 96, I_GO = 16 * 32, I_KV = 16 * 16, I_Q = 16 * 24, I_AO = 12 * 32;
    constexpr int NITEMS = 4 * I_FI + 4 * I_FO + I_GI + I_GO + I_KV + I_Q + I_AO;
    for (int it = gw; it < NITEMS; it += NGW) {
        int r = it;
        if (r < 4 * I_FI) { const int mi = r / I_FI, l = mi >> 1, i = mi & 1; transpose_item<1>(a.in[6] + (size_t)mi * D * 2 * FF, D, 2 * FF, 2 * FF, (bf16*)(ws + W_FI) + (size_t)mi * 2 * FF * D, gains + (l * 3 + (i ? 2 : 0)) * D, scr, r % I_FI, lane); continue; } r -= 4 * I_FI;
        if (r < 4 * I_FO) { const int mi = r / I_FO; transpose_item<0>(a.in[7] + (size_t)mi * FF * D, FF, D, D, (bf16*)(ws + W_FO) + (size_t)mi * D * FF, nullptr, scr, r % I_FO, lane); continue; } r -= 4 * I_FO;
        if (r < I_GI) { transpose_item<2>(a.in[8], D, 3088, NGLA, (bf16*)(ws + W_GI), gains + 1 * D, scr, r, lane); continue; } r -= I_GI;
        if (r < I_GO) { transpose_item<0>(a.in[12], D, D, D, (bf16*)(ws + W_GO), nullptr, scr, r, lane); continue; } r -= I_GO;
        if (r < I_KV) { transpose_item<0>(a.in[14], D, 512, 512, (bf16*)(ws + W_KV), a.in[13], scr, r, lane); continue; } r -= I_KV;
        if (r < I_Q) { transpose_item<0>(a.in[16], D, 768, 768, (bf16*)(ws + W_Q), gains + 4 * D, scr, r, lane); continue; } r -= I_Q;
        transpose_item<0>(a.in[18], 768, D, D, (bf16*)(ws + W_AO), nullptr, scr, r, lane);
    }
    float* ssq = (float*)(ws + WS_SSQ);
    for (int m = gw; m < M; m += NGW) {
        const float* xr = m < MP ? a.in[0] + (size_t)m * D : a.in[1] + (size_t)(m - MP) * D;
        float s = 0.f;
        f32x4 xin[4];
#pragma unroll
        for (int j = 0; j < 4; ++j) xin[j] = *((const f32x4*)xr + lane + 64 * j);
        asm volatile("" ::: "memory");
#pragma unroll
        for (int j = 0; j < 4; ++j) {
            const f32x4 v = xin[j];
            *((f32x4*)(a.out + (size_t)m * D) + lane + 64 * j) = v;
            u32x2 w; w.x = cvtpk(v[0], v[1]); w.y = cvtpk(v[2], v[3]);
            *((u32x2*)((bf16*)(ws + WS_XB) + (size_t)m * D) + lane + 64 * j) = w;
            s += (v[0] * v[0] + v[1] * v[1]) + (v[2] * v[2] + v[3] * v[3]);
        }
        s = wave_sum(s);
        if (lane == 0) ssq[m] = s;
    }
    const int gt = blockIdx.x * 512 + tid, NGT = G * 512;
    for (int i = gt; i < 5 * M; i += NGT) ssq[M + i] = 0.f;
    for (int i = gt; i < 2056 * 32; i += NGT) {
        const int p = i >> 5, f = i & 31; const int pos = p < 2048 ? p : 8192 + (p - 2048);
        const double inv = pow(10000.0, -(double)f / 32.0); double sn, cs; sincos((double)pos * inv, &sn, &cs);
        ((float*)(ws + W_ROPE))[2 * i] = (float)cs; ((float*)(ws + W_ROPE))[2 * i + 1] = (float)sn;
    }
    for (int i = gt; i < 32 * D; i += NGT) { const int c = i >> 10, k = i & 1023; ((bf16*)(ws + W_GLR))[i] = c < 16 ? f2bf(a.in[8][(size_t)k * 3088 + 2048 + c] * gains[1 * D + k]) : (bf16)0; }
}

constexpr size_t U2_QIMG = 0, U2_PBE = 18 * MiB, U2_KDIMG = 36 * MiB, U2_VT = 54 * MiB;
constexpr int PBE_BYTES = 7168;
DI float logsig16(float z) { return -(fmaxf(-z, 0.f) + __logf(1.f + __expf(-fabsf(z)))) * (1.f / 16.f); }
DI void gla_prep(const Args& a, LAS unsigned char* lds, int tid, int lane, int wave) {
    unsigned char* ws = a.ws;
    LAS unsigned char* QI = lds;
    LAS unsigned char* KI = lds + 65536;
    LAS float* glr = (LAS float*)(lds + 131072);
    const bf16* qkvr = (const bf16*)(ws + WS_U1);
    const bf16* XBp = (const bf16*)(ws + WS_XB);
    const bf16* WgT = (const bf16*)(ws + W_GLR);
    unsigned char* QIMG = ws + WS_U2 + U2_QIMG; unsigned char* PBE = ws + WS_U2 + U2_PBE; unsigned char* KDIMG = ws + WS_U2 + U2_KDIMG; bf16* VT = (bf16*)(ws + WS_U2 + U2_VT);
    const float* ssq1 = (const float*)(ws + WS_SSQ) + 1 * M;
    const int r = lane & 31, hh = lane >> 5;
    for (int ch = blockIdx.x; ch < NCH; ch += gridDim.x) {
        const bool smp = ch >= 256; const int T = smp ? 8 : 64; const int row0 = smp ? MP + 8 * (ch - 256) : 64 * ch;
        {
            f32x16 P0, P1;
#pragma unroll
            for (int i = 0; i < 16; ++i) { P0[i] = 0.f; P1[i] = 0.f; }
            const bf16* x0 = XBp + (size_t)(row0 + r) * D + 128 * wave + 8 * hh;
            const bf16* wg = WgT + (size_t)r * D + 128 * wave + 8 * hh;
#pragma unroll
            for (int ks = 0; ks < 8; ++ks) {
                const bf16x8 bw = *(const bf16x8*)(wg + 16 * ks);
                P0 = MFMA32(*(const bf16x8*)(x0 + 16 * ks), bw, P0);
                P1 = MFMA32(*(const bf16x8*)(x0 + (size_t)32 * D + 16 * ks), bw, P1);
            }
            LAS float* part = (LAS float*)QI + wave * 1024;
            if (r < 16) {
#pragma unroll
                for (int i = 0; i < 16; ++i) { part[crow(i, hh) * 16 + r] = P0[i]; part[(32 + crow(i, hh)) * 16 + r] = P1[i]; }
            }
        }
        __syncthreads();
#pragma unroll
        for (int k2 = 0; k2 < 2; ++k2) {
            const int idx = tid + 512 * k2, t = idx >> 4;
            float sacc = 0.f;
#pragma unroll
            for (int w8 = 0; w8 < 8; ++w8) sacc += ((LAS float*)QI)[w8 * 1024 + idx];
            const float rstd = t < T ? rsqrtf(ssq1[row0 + t] * (1.f / D) + EPS) : 0.f;
            glr[idx] = t < T ? sacc * rstd : 0.f;
        }
        __syncthreads();
        {
            const int col = tid, h = col >> 7, d = col & 127;
            float w2[16];
#pragma unroll
            for (int i = 0; i < 16; ++i) w2[i] = a.in[9][i * 512 + col];
            const float bias = a.in[10][col];
            float total = 0.f;
            for (int t = 0; t < T; ++t) { float z = bias;
#pragma unroll
                for (int i = 0; i < 16; ++i) z += glr[t * 16 + i] * w2[i];
                total += logsig16(z); }
            float cum = 0.f;
            const int dp = swz(d), pc = dp >> 3, wi = dp & 7;
            LAS unsigned char* qi = QI + h * 16384 + wi * 2;
            LAS unsigned char* ki = KI + h * 16384 + wi * 2;
            unsigned char* kdrow = KDIMG + (size_t)(ch * 4 + h) * 16384 + d * 128;
            const int dsw = (d >> 1) & 7;
            for (int t16 = 0; t16 < 4; ++t16) {
                unsigned kd[8];
#pragma unroll
                for (int i = 0; i < 8; ++i) kd[i] = 0u;
                float qv[16], kv[16];
#pragma unroll
                for (int tt = 0; tt < 16; ++tt) { const int t = 16 * t16 + tt; const bool valid = t < T;
                    qv[tt] = valid ? bf2f(qkvr[(size_t)(row0 + t) * NGLA + col]) : 0.f; kv[tt] = valid ? bf2f(qkvr[(size_t)(row0 + t) * NGLA + 512 + col]) : 0.f; }
#pragma unroll
                for (int tt = 0; tt < 16; ++tt) {
                    const int t = 16 * t16 + tt;
                    if (t < T) { float z = bias;
#pragma unroll
                        for (int i = 0; i < 16; ++i) z += glr[t * 16 + i] * w2[i];
                        cum += logsig16(z); }
                    const int off = t * 256 + ((pc ^ tt) << 4);
                    *(LAS bf16*)(qi + off) = f2bf(qv[tt] * 0.08838834764831845f * __expf(cum));
                    *(LAS bf16*)(ki + off) = f2bf(kv[tt] * __expf(-cum));
                    const unsigned kdv = f2bf(kv[tt] * __expf(total - cum));
                    const int p = (tt & ~12) | ((tt & 4) << 1) | ((tt & 8) >> 1);
                    kd[p >> 1] |= kdv << (16 * (p & 1));
                }
                u32x4 o0, o1; o0.x = kd[0]; o0.y = kd[1]; o0.z = kd[2]; o0.w = kd[3]; o1.x = kd[4]; o1.y = kd[5]; o1.z = kd[6]; o1.w = kd[7];
                *(u32x4*)(kdrow + (((2 * t16) ^ dsw) << 4)) = o0; *(u32x4*)(kdrow + (((2 * t16 + 1) ^ dsw) << 4)) = o1;
            }
            *(float*)(PBE + (size_t)(ch * 4 + h) * PBE_BYTES + 6144 + d * 4) = __expf(total);
        }
#pragma unroll 1
        for (int rep = 0; rep < 2; ++rep) {
            const int vc = tid + 512 * rep, h = vc >> 8, vv = vc & 255;
            bf16* vt = VT + ((size_t)(ch * 4 + h) * 256 + vv) * 64;
            for (int t16 = 0; t16 < 4; ++t16) {
                unsigned kd[8];
#pragma unroll
                for (int i = 0; i < 8; ++i) kd[i] = 0u;
#pragma unroll
                for (int tt = 0; tt < 16; ++tt) {
                    const int t = 16 * t16 + tt;
                    const unsigned v = t < T ? (unsigned)qkvr[(size_t)(row0 + t) * NGLA + 1024 + vc] : 0u;
                    const int p = (tt & ~12) | ((tt & 4) << 1) | ((tt & 8) >> 1);
                    kd[p >> 1] |= v << (16 * (p & 1));
                }
                u32x4 o0, o1; o0.x = kd[0]; o0.y = kd[1]; o0.z = kd[2]; o0.w = kd[3]; o1.x = kd[4]; o1.y = kd[5]; o1.z = kd[6]; o1.w = kd[7];
                *(u32x4*)(vt + 16 * t16) = o0; *(u32x4*)(vt + 16 * t16 + 8) = o1;
            }
        }
        __syncthreads();
        {
            const int h = wave >> 1, half = wave & 1;
            const LAS unsigned char* qi = QI + h * 16384; const LAS unsigned char* ki = KI + h * 16384;
            unsigned char* pb = PBE + (size_t)(ch * 4 + h) * PBE_BYTES + lane * 16;
            f32x16 A0, A1;
#pragma unroll
            for (int i = 0; i < 16; ++i) { A0[i] = 0.f; A1[i] = 0.f; }
            if (half == 0) {
#pragma unroll
                for (int s = 0; s < 8; ++s) {
                    const int po = ((2 * s + hh) ^ (r & 15)) << 4;
                    const bf16x8 k0 = *(const LAS bf16x8*)(ki + r * 256 + po);
                    A0 = MFMA32(k0, *(const LAS bf16x8*)(qi + r * 256 + po), A0);
                    A1 = MFMA32(k0, *(const LAS bf16x8*)(qi + (32 + r) * 256 + po), A1);
                }
#pragma unroll
                for (int i = 0; i < 16; ++i) if (crow(i, hh) > r) A0[i] = 0.f;
                *(bf16x8*)(pb + 0 * 1024) = pack8<0>(A0); *(bf16x8*)(pb + 1 * 1024) = pack8<1>(A0);
                *(bf16x8*)(pb + 2 * 1024) = pack8<0>(A1); *(bf16x8*)(pb + 3 * 1024) = pack8<1>(A1);
            } else {
#pragma unroll
                for (int s = 0; s < 8; ++s) {
                    const int po = ((2 * s + hh) ^ (r & 15)) << 4;
                    A0 = MFMA32(*(const LAS bf16x8*)(ki + (32 + r) * 256 + po), *(const LAS bf16x8*)(qi + (32 + r) * 256 + po), A0);
                }
#pragma unroll
                for (int i = 0; i < 16; ++i) if (crow(i, hh) > r) A0[i] = 0.f;
                *(bf16x8*)(pb + 4 * 1024) = pack8<0>(A0); *(bf16x8*)(pb + 5 * 1024) = pack8<1>(A0);
            }
        }
        {
            unsigned char* dst = QIMG + (size_t)ch * 65536;
#pragma unroll
            for (int i = 0; i < 8; ++i) *(u32x4*)(dst + (i * 512 + tid) * 16) = *(const LAS u32x4*)(QI + (i * 512 + tid) * 16);
        }
        __syncthreads();
    }
}

constexpr int REC_SLOT = 40960, REC_SSQ = 81920;
DI void rec_stage(const unsigned char* QIMG, const unsigned char* KDIMG, const unsigned char* PBE, int ch, int h, LAS unsigned char* slot, int tid, int lane, int wave) {
    const unsigned char* q = QIMG + (size_t)(ch * 4 + h) * 16384; const unsigned char* k = KDIMG + (size_t)(ch * 4 + h) * 16384; const unsigned char* p = PBE + (size_t)(ch * 4 + h) * PBE_BYTES;
#pragma unroll
    for (int i = 0; i < 2; ++i) {
        __builtin_amdgcn_global_load_lds((const unsigned*)(q + (i * 512 + tid) * 16), (LAS unsigned*)(slot + i * 8192 + wave * 1024), 16, 0, 0);
        __builtin_amdgcn_global_load_lds((const unsigned*)(k + (i * 512 + tid) * 16), (LAS unsigned*)(slot + 16384 + i * 8192 + wave * 1024), 16, 0, 0);
    }
    if (wave < 7) __builtin_amdgcn_global_load_lds((const unsigned*)(p + tid * 16), (LAS unsigned*)(slot + 32768 + wave * 1024), 16, 0, 0);
}
DI void gla_rec(const Args& a, LAS unsigned char* lds, int tid, int lane, int wave) {
    unsigned char* ws = a.ws;
    LAS float* ssqbuf = (LAS float*)(lds + REC_SSQ);
    const bf16* qkvr = (const bf16*)(ws + WS_U1);
    const unsigned char* QIMG = ws + WS_U2 + U2_QIMG; const unsigned char* PBE = ws + WS_U2 + U2_PBE; const unsigned char* KDIMG = ws + WS_U2 + U2_KDIMG; const bf16* VT = (const bf16*)(ws + WS_U2 + U2_VT);
    bf16* AG = (bf16*)(ws + WS_U3);
    const float* gnorm = a.in[11];
    const int r = lane & 31, hh = lane >> 5, w = wave;
    for (int u = blockIdx.x; u < 160; u += gridDim.x) {
        const bool smp = u >= 32;
        int b, h, nchunk, chunk0, T;
        if (!smp) { b = u >> 2; h = u & 3; nchunk = 32; chunk0 = b * 32; T = 64; }
        else { const int uu = u - 32; b = uu >> 2; h = uu & 3; nchunk = 1; chunk0 = 256 + b; T = 8; }
        rec_stage(QIMG, KDIMG, PBE, chunk0, h, lds, tid, lane, wave);
        f32x16 S[4];
#pragma unroll
        for (int dt = 0; dt < 4; ++dt)
#pragma unroll
            for (int i = 0; i < 16; ++i) S[dt][i] = 0.f;
        if (smp) {
            const float* s0 = a.in[2] + ((size_t)(b * 4 + h) * 128 + 4 * hh) * 256 + 32 * w + r;
#pragma unroll
            for (int dt = 0; dt < 4; ++dt)
#pragma unroll
                for (int g = 0; g < 4; ++g) { const float* pp = s0 + (size_t)(32 * dt + 8 * g) * 256;
                    S[dt][4 * g] = pp[0]; S[dt][4 * g + 1] = pp[256]; S[dt][4 * g + 2] = pp[512]; S[dt][4 * g + 3] = pp[768];
                    asm volatile("" ::: "memory"); }
        }
        f32x4 gn[4];
#pragma unroll
        for (int g = 0; g < 4; ++g) gn[g] = *(const f32x4*)(gnorm + 32 * w + 8 * g + 4 * hh);
        bf16x8 vf[4];
        {
            const bf16* vt = VT + ((size_t)(chunk0 * 4 + h) * 256 + 32 * w) * 64;
#pragma unroll
            for (int js = 0; js < 4; ++js) vf[js] = *(const bf16x8*)(vt + r * 64 + 16 * js + 8 * hh);
        }
        asm volatile("s_waitcnt vmcnt(0)" ::: "memory");
        __syncthreads();
        for (int c = 0; c < nchunk; ++c) {
            const int ch = chunk0 + c; const int row0 = smp ? MP + 8 * b : b * SEQ + 64 * c;
            LAS unsigned char* cur = lds + (c & 1) * REC_SLOT;
            u32x2 rg[2][4];
            if (c + 1 < nchunk) rec_stage(QIMG, KDIMG, PBE, ch + 1, h, lds + ((c + 1) & 1) * REC_SLOT, tid, lane, wave);
#pragma unroll
            for (int it = 0; it < 2; ++it)
#pragma unroll
                for (int g = 0; g < 4; ++g) { const int tok = 32 * it + r; const size_t row = (size_t)row0 + (tok < T ? tok : 0);
                    rg[it][g] = *(const u32x2*)(qkvr + row * NGLA + 2048 + h * 256 + 32 * w + 8 * g + 4 * hh); }
            f32x16 O[2];
#pragma unroll
            for (int i = 0; i < 16; ++i) { O[0][i] = 0.f; O[1][i] = 0.f; }
#pragma unroll
            for (int s = 0; s < 8; ++s) {
                const int po = ((2 * s + hh) ^ (r & 15)) << 4;
                const bf16x8 ps = (s & 1) ? pack8<1>(S[s >> 1]) : pack8<0>(S[s >> 1]);
                O[0] = MFMA32(ps, *(const LAS bf16x8*)(cur + r * 256 + po), O[0]);
                O[1] = MFMA32(ps, *(const LAS bf16x8*)(cur + (32 + r) * 256 + po), O[1]);
            }
            {
                const LAS unsigned char* pb = cur + 32768 + lane * 16;
                O[0] = MFMA32(vf[0], *(const LAS bf16x8*)(pb + 0 * 1024), O[0]); O[0] = MFMA32(vf[1], *(const LAS bf16x8*)(pb + 1 * 1024), O[0]);
                O[1] = MFMA32(vf[0], *(const LAS bf16x8*)(pb + 2 * 1024), O[1]); O[1] = MFMA32(vf[1], *(const LAS bf16x8*)(pb + 3 * 1024), O[1]);
                O[1] = MFMA32(vf[2], *(const LAS bf16x8*)(pb + 4 * 1024), O[1]); O[1] = MFMA32(vf[3], *(const LAS bf16x8*)(pb + 5 * 1024), O[1]);
            }
            LAS float* sb = ssqbuf + (c & 1) * 512;
#pragma unroll
            for (int it = 0; it < 2; ++it) { float ss = 0.f;
#pragma unroll
                for (int i = 0; i < 16; ++i) ss += O[it][i] * O[it][i];
                ss += __shfl_xor(ss, 32);
                if (hh == 0) sb[w * 64 + 32 * it + r] = ss; }
#pragma unroll
            for (int dt = 0; dt < 4; ++dt) {
#pragma unroll
                for (int g = 0; g < 4; ++g) { const f32x4 el = *(const LAS f32x4*)(cur + 32768 + 6144 + (32 * dt + 8 * g + 4 * hh) * 4);
                    S[dt][4 * g] *= el[0]; S[dt][4 * g + 1] *= el[1]; S[dt][4 * g + 2] *= el[2]; S[dt][4 * g + 3] *= el[3]; }
#pragma unroll
                for (int js = 0; js < 4; ++js) { const bf16x8 kd = *(const LAS bf16x8*)(cur + 16384 + (32 * dt + r) * 128 + (((2 * js + hh) ^ ((r >> 1) & 7)) << 4)); S[dt] = MFMA32(kd, vf[js], S[dt]); }
            }
            if (c + 1 < nchunk) {
                const bf16* vt = VT + ((size_t)((ch + 1) * 4 + h) * 256 + 32 * w) * 64;
#pragma unroll
                for (int js = 0; js < 4; ++js) vf[js] = *(const bf16x8*)(vt + r * 64 + 16 * js + 8 * hh);
            }
            __syncthreads();
#pragma unroll
            for (int it = 0; it < 2; ++it) {
                float tot = 0.f;
#pragma unroll
                for (int ww = 0; ww < 8; ++ww) tot += sb[ww * 64 + 32 * it + r];
                const float rstd = rsqrtf(tot * (1.f / 256.f) + EPS);
                const int tok = 32 * it + r;
                if (tok < T) {
                    const size_t row = (size_t)row0 + tok;
#pragma unroll
                    for (int g = 0; g < 4; ++g) {
                        const int vb = 32 * w + 8 * g + 4 * hh;
                        const u32x2 rr = rg[it][g];
                        const float r0 = __uint_as_float(rr.x << 16), r1 = __uint_as_float(rr.x & 0xffff0000u), r2 = __uint_as_float(rr.y << 16), r3 = __uint_as_float(rr.y & 0xffff0000u);
                        u32x2 o; o.x = cvtpk(O[it][4 * g] * rstd * gn[g][0] * silu(r0), O[it][4 * g + 1] * rstd * gn[g][1] * silu(r1));
                        o.y = cvtpk(O[it][4 * g + 2] * rstd * gn[g][2] * silu(r2), O[it][4 * g + 3] * rstd * gn[g][3] * silu(r3));
                        *(u32x2*)(AG + row * D + h * 256 + vb) = o;
                    }
                }
            }
            asm volatile("s_waitcnt vmcnt(0)" ::: "memory");
            __syncthreads();
        }
        float* so = a.out + (smp ? O_SS : O_SP) + ((size_t)(b * 4 + h) * 128 + 4 * hh) * 256 + 32 * w + r;
#pragma unroll
        for (int dt = 0; dt < 4; ++dt)
#pragma unroll
            for (int g = 0; g < 4; ++g) { float* pp = so + (size_t)(32 * dt + 8 * g) * 256;
                pp[0] = S[dt][4 * g]; pp[256] = S[dt][4 * g + 1]; pp[512] = S[dt][4 * g + 2]; pp[768] = S[dt][4 * g + 3]; }
        __syncthreads();
    }
}

DI void kv_post_item(const Args& a, int item, int tid) {
    unsigned char* ws = a.ws;
    const float* kvraw = (const float*)(ws + WS_U2);
    bf16* Kb = (bf16*)(ws + WS_U3); bf16* VTd = Kb + (size_t)MP * 256;
    const float* rope = (const float*)(ws + W_ROPE);
    const int t = tid >> 3, sub = tid & 7, hd = sub & 3, isV = sub >> 2;
    const int row = 64 * item + t; const bool prompt = row < MP;
    const float* src = kvraw + (size_t)row * 512 + isV * 256 + hd * 64;
    float v[64];
#pragma unroll
    for (int i = 0; i < 16; ++i) { const f32x4 x = *(const f32x4*)(src + 4 * i); v[4 * i] = x[0]; v[4 * i + 1] = x[1]; v[4 * i + 2] = x[2]; v[4 * i + 3] = x[3]; }
    if (!isV) {
        float ss = 0.f;
#pragma unroll
        for (int i = 0; i < 64; ++i) ss += v[i] * v[i];
        const float rk = rsqrtf(ss * (1.f / 64.f) + EPS);
        const int pidx = prompt ? (row & 2047) : 2048 + ((row - MP) & 7);
        const float* kn = a.in[15];
#pragma unroll
        for (int i = 0; i < 32; ++i) {
            const float x1 = v[i] * rk * kn[i], x2 = v[i + 32] * rk * kn[i + 32];
            const float cs = rope[(pidx * 32 + i) * 2], sn = rope[(pidx * 32 + i) * 2 + 1];
            v[i] = x1 * cs - x2 * sn; v[i + 32] = x1 * sn + x2 * cs;
        }
        float* ok = prompt ? a.out + O_KP + (size_t)row * 256 + hd * 64 : a.out + O_KS + (size_t)(row - MP) * 256 + hd * 64;
#pragma unroll
        for (int i = 0; i < 16; ++i) { f32x4 x; x[0] = v[4 * i]; x[1] = v[4 * i + 1]; x[2] = v[4 * i + 2]; x[3] = v[4 * i + 3]; *(f32x4*)(ok + 4 * i) = x; }
        if (prompt) {
            bf16* kb = Kb + (size_t)row * 256 + hd * 64;
#pragma unroll
            for (int i = 0; i < 8; ++i) { u32x4 o; o.x = cvtpk(v[8 * i], v[8 * i + 1]); o.y = cvtpk(v[8 * i + 2], v[8 * i + 3]); o.z = cvtpk(v[8 * i + 4], v[8 * i + 5]); o.w = cvtpk(v[8 * i + 6], v[8 * i + 7]); *(u32x4*)(kb + 8 * i) = o; }
        }
    } else {
        float* ov = prompt ? a.out + O_VP + (size_t)row * 256 + hd * 64 : a.out + O_VS + (size_t)(row - MP) * 256 + hd * 64;
#pragma unroll
        for (int i = 0; i < 16; ++i) { f32x4 x; x[0] = v[4 * i]; x[1] = v[4 * i + 1]; x[2] = v[4 * i + 2]; x[3] = v[4 * i + 3]; *(f32x4*)(ov + 4 * i) = x; }
        if (prompt) {
            const int b = row >> 11, tk = row & 2047;
#pragma unroll
            for (int gi = 0; gi < 3; ++gi) {
                const int dl = gi == 0 ? 1 : (gi == 1 ? 4 : 16), L = SEQ / dl;
                const int pos = (tk % dl) * L + swz(tk / dl);
                bf16* vt = VTd + (size_t)gi * 8 * 4 * 64 * SEQ + ((size_t)(b * 4 + hd) * 64) * SEQ + pos;
#pragma unroll
                for (int i = 0; i < 64; ++i) vt[(size_t)i * SEQ] = f2bf(v[i]);
            }
        }
    }
}

DI void attn_tile(const Args& a, int b, int j, int g, int res, int a0, int lane) {
    unsigned char* ws = a.ws;
    const bf16* qraw = (const bf16*)(ws + WS_U1);
    const bf16* Kb = (const bf16*)(ws + WS_U3); const bf16* VTd = Kb + (size_t)MP * 256;
    float* OG = (float*)(ws + WS_U2); float* LSE = (float*)(ws + WS_LSE);
    const float* rope = (const float*)(ws + W_ROPE);
    const float* qn = a.in[17];
    const int r = lane & 31, hh = lane >> 5;
    const int dl = g == 0 ? 1 : (g == 1 ? 4 : 16), L = SEQ / dl;
    const int tq = dl * (a0 + r) + res; const size_t row = (size_t)b * SEQ + tq;
    const int qh = g * 4 + j;
    bf16x8 qf[4];
    {
        float x[4][8];
#pragma unroll
        for (int s = 0; s < 4; ++s) { const u32x4 v = *(const u32x4*)(qraw + row * 768 + qh * 64 + 16 * s + 8 * hh);
            x[s][0] = __uint_as_float(v.x << 16); x[s][1] = __uint_as_float(v.x & 0xffff0000u); x[s][2] = __uint_as_float(v.y << 16); x[s][3] = __uint_as_float(v.y & 0xffff0000u);
            x[s][4] = __uint_as_float(v.z << 16); x[s][5] = __uint_as_float(v.z & 0xffff0000u); x[s][6] = __uint_as_float(v.w << 16); x[s][7] = __uint_as_float(v.w & 0xffff0000u); }
        float ss = 0.f;
#pragma unroll
        for (int s = 0; s < 4; ++s)
#pragma unroll
            for (int e = 0; e < 8; ++e) ss += x[s][e] * x[s][e];
        ss += __shfl_xor(ss, 32);
        const float rq = rsqrtf(ss * (1.f / 64.f) + EPS) ;
#pragma unroll
        for (int s = 0; s < 2; ++s)
#pragma unroll
            for (int e = 0; e < 8; ++e) {
                const int i = 16 * s + 8 * hh + e;
                const float x1 = x[s][e] * rq * qn[i], x2 = x[s + 2][e] * rq * qn[i + 32];
                const float cs = rope[(tq * 32 + i) * 2], sn = rope[(tq * 32 + i) * 2 + 1];
                x[s][e] = (x1 * cs - x2 * sn) * 0.125f; x[s + 2][e] = (x1 * sn + x2 * cs) * 0.125f;
            }
#pragma unroll
        for (int s = 0; s < 4; ++s) { u32x4 p; p.x = cvtpk(x[s][0], x[s][1]); p.y = cvtpk(x[s][2], x[s][3]); p.z = cvtpk(x[s][4], x[s][5]); p.w = cvtpk(x[s][6], x[s][7]); qf[s] = __builtin_bit_cast(bf16x8, p); }
    }
    f32x16 ST[5];
#pragma unroll
    for (int kt = 0; kt < 5; ++kt) {
        int ks = a0 - 128 + 32 * kt + r; ks = ks < 0 ? 0 : ks;
        const bf16* kp = Kb + ((size_t)b * SEQ + dl * ks + res) * 256 + j * 64 + 8 * hh;
#pragma unroll
        for (int i = 0; i < 16; ++i) ST[kt][i] = 0.f;
#pragma unroll
        for (int s = 0; s < 4; ++s) { const bf16x8 kf = *(const bf16x8*)(kp + 16 * s); ST[kt] = MFMA32(kf, qf[s], ST[kt]); }
        asm volatile("" ::: "memory");
    }
    float mx = -INFINITY;
#pragma unroll
    for (int kt = 0; kt < 5; ++kt)
#pragma unroll
        for (int i = 0; i < 16; ++i) {
            const int krel = 32 * kt - 128 + crow(i, hh);
            const bool valid = (krel <= r) && (krel + 128 >= r) && (a0 + krel >= 0);
            ST[kt][i] = valid ? ST[kt][i] : -INFINITY;
            mx = fmaxf(mx, ST[kt][i]);
        }
    mx = fmaxf(mx, __shfl_xor(mx, 32));
    float den = 0.f;
#pragma unroll
    for (int kt = 0; kt < 5; ++kt)
#pragma unroll
        for (int i = 0; i < 16; ++i) { const float p = __expf(ST[kt][i] - mx); ST[kt][i] = p; den += p; }
    den += __shfl_xor(den, 32);
    f32x16 OT[2];
#pragma unroll
    for (int i = 0; i < 16; ++i) { OT[0][i] = 0.f; OT[1][i] = 0.f; }
    const bf16* vbase = VTd + (size_t)g * 8 * 4 * 64 * SEQ + ((size_t)(b * 4 + j) * 64 + r) * SEQ + res * L + 8 * hh;
#pragma unroll
    for (int kt = 0; kt < 5; ++kt) {
        const bf16x8 p0 = pack8<0>(ST[kt]), p1 = pack8<1>(ST[kt]);
        int s0 = a0 - 128 + 32 * kt; const int s0a = s0 < 0 ? 0 : s0; const int s0b = s0 + 16 < 0 ? 0 : s0 + 16;
        OT[0] = MFMA32(*(const bf16x8*)(vbase + s0a), p0, OT[0]);
        OT[1] = MFMA32(*(const bf16x8*)(vbase + (size_t)32 * SEQ + s0a), p0, OT[1]);
        OT[0] = MFMA32(*(const bf16x8*)(vbase + s0b), p1, OT[0]);
        OT[1] = MFMA32(*(const bf16x8*)(vbase + (size_t)32 * SEQ + s0b), p1, OT[1]);
        asm volatile("" ::: "memory");
    }
    const float inv = 1.f / den;
#pragma unroll
    for (int mt = 0; mt < 2; ++mt)
#pragma unroll
        for (int q = 0; q < 4; ++q) { f32x4 o; o[0] = OT[mt][4 * q] * inv; o[1] = OT[mt][4 * q + 1] * inv; o[2] = OT[mt][4 * q + 2] * inv; o[3] = OT[mt][4 * q + 3] * inv;
            *(f32x4*)(OG + row * 768 + qh * 64 + 32 * mt + 8 * q + 4 * hh) = o; }
    if (hh == 0) LSE[row * 12 + qh] = mx + __logf(den);
}

DI void attn_sample_unit(const Args& a, LAS unsigned char* lds, int unit, int lane, int wave) {
    unsigned char* ws = a.ws;
    const bf16* qraw = (const bf16*)(ws + WS_U1);
    bf16* AA = (bf16*)(ws + WS_U1 + 32 * MiB);
    const float* rope = (const float*)(ws + W_ROPE);
    const float* qn = a.in[17];
    LAS float* qs = (LAS float*)(lds + 8192 + wave * 1024);
    LAS float* ps = qs + 64;
    const int b = unit >> 5, j = (unit >> 3) & 3, t = unit & 7;
    const size_t row = (size_t)MP + 8 * b + t;
    const float* cK = a.in[3]; const float* cV = a.in[4];
    const float* nK = a.out + O_KS; const float* nV = a.out + O_VS;
    float og0 = 0.f, og1 = 0.f, og2 = 0.f, l0 = 0.f, l1 = 0.f, l2 = 0.f;
#pragma unroll 1
    for (int g = 0; g < 3; ++g) {
        const int dl = g == 0 ? 1 : (g == 1 ? 4 : 16);
        const int qh = g * 4 + j;
        const float x = bf2f(qraw[row * 768 + qh * 64 + lane]);
        const float ss = wave_sum(x * x);
        const float xn = x * rsqrtf(ss * (1.f / 64.f) + EPS) * qn[lane];
        const float xp = __shfl_xor(xn, 32);
        const int i = lane & 31;
        const float cs = rope[((2048 + t) * 32 + i) * 2], sn = rope[((2048 + t) * 32 + i) * 2 + 1];
        const float y = lane < 32 ? xn * cs - xp * sn : xp * sn + xn * cs;
        qs[lane] = y * 0.125f;
        asm volatile("s_waitcnt lgkmcnt(0)" ::: "memory");
        float mx = -INFINITY;
#pragma unroll 1
        for (int rr = 0; rr < 3; ++rr) {
            const int jj = 64 * rr + lane;
            float dot = -INFINITY;
            if (jj <= 128) {
                const int srow = 2048 + t - dl * jj;
                const float* kp = srow >= 2048 ? nK + ((size_t)(8 * b + srow - 2048) * 4 + j) * 64 : cK + (((size_t)b * 2048 + srow) * 4 + j) * 64;
                float acc = 0.f;
#pragma unroll
                for (int q = 0; q < 16; ++q) { const f32x4 kv = *(const f32x4*)(kp + 4 * q); const f32x4 qv = *(const LAS f32x4*)(qs + 4 * q); acc += kv[0] * qv[0] + kv[1] * qv[1] + kv[2] * qv[2] + kv[3] * qv[3]; }
                dot = acc;
            }
            ps[jj] = dot; mx = fmaxf(mx, dot);
            asm volatile("" ::: "memory");
        }
        mx = wave_max(mx);
        float ds = 0.f;
#pragma unroll 1
        for (int rr = 0; rr < 3; ++rr) { const int jj = 64 * rr + lane; const float pv = __expf(ps[jj] - mx); ps[jj] = pv; ds += pv; }
        const float den = wave_sum(ds);
        asm volatile("s_waitcnt lgkmcnt(0)" ::: "memory");
        float o = 0.f;
#pragma unroll 16
        for (int jj = 0; jj <= 128; ++jj) {
            const float pj = ps[jj];
            const int srow = 2048 + t - dl * jj;
            const float* vp = srow >= 2048 ? nV + ((size_t)(8 * b + srow - 2048) * 4 + j) * 64 : cV + (((size_t)b * 2048 + srow) * 4 + j) * 64;
            o += pj * vp[lane];
        }
        { const float ov = o / den, lv = mx + __logf(den); if (g == 0) { og0 = ov; l0 = lv; } else if (g == 1) { og1 = ov; l1 = lv; } else { og2 = ov; l2 = lv; } }
        asm volatile("s_waitcnt lgkmcnt(0)" ::: "memory");
    }
    const float lm = fmaxf(fmaxf(l0, l1), l2);
    const float e0 = __expf(l0 - lm), e1 = __expf(l1 - lm), e2 = __expf(l2 - lm), is = 1.f / (e0 + e1 + e2);
    AA[row * 768 + (0 + j) * 64 + lane] = f2bf(og0 * e0 * is);
    AA[row * 768 + (4 + j) * 64 + lane] = f2bf(og1 * e1 * is);
    AA[row * 768 + (8 + j) * 64 + lane] = f2bf(og2 * e2 * is);
}

DI void attn_phase(const Args& a, LAS unsigned char* lds, int tid, int lane, int wave) {
    unsigned char* ws = a.ws;
    const int G = gridDim.x, GP = G > 1 ? G / 2 : 1;
    if ((int)blockIdx.x < GP) {
        const float* OG = (const float*)(ws + WS_U2); const float* LSE = (const float*)(ws + WS_LSE);
        bf16* AA = (bf16*)(ws + WS_U1 + 32 * MiB);
        for (int u = blockIdx.x; u < 128; u += GP) {
            const int b = u >> 4, j = (u >> 2) & 3, sp = u & 3, T0 = 512 * sp;
            for (int jb = wave; jb < 48; jb += 8) {
                const int g = jb >> 4, q = jb & 15;
                const int dl = g == 0 ? 1 : (g == 1 ? 4 : 16), tpr = 16 / dl;
                const int res = q / tpr, a0 = T0 / dl + 32 * (q % tpr);
                attn_tile(a, b, j, g, res, a0, lane);
            }
            __builtin_amdgcn_fence(__ATOMIC_RELEASE, "agent");
            __syncthreads();
            __builtin_amdgcn_fence(__ATOMIC_ACQUIRE, "agent");
            {
                const size_t row = (size_t)b * SEQ + T0 + tid;
                const float l0 = LSE[row * 12 + j], l1 = LSE[row * 12 + 4 + j], l2 = LSE[row * 12 + 8 + j];
                const float lm = fmaxf(fmaxf(l0, l1), l2);
                const float e0 = __expf(l0 - lm), e1 = __expf(l1 - lm), e2 = __expf(l2 - lm), is = 1.f / (e0 + e1 + e2);
#pragma unroll
                for (int g = 0; g < 3; ++g) {
                    const float wg = (g == 0 ? e0 : (g == 1 ? e1 : e2)) * is;
                    const float* src = OG + row * 768 + (g * 4 + j) * 64; bf16* dst = AA + row * 768 + (g * 4 + j) * 64;
                    f32x4 xg[16];
#pragma unroll
                    for (int i = 0; i < 16; ++i) xg[i] = *(const f32x4*)(src + 4 * i);
                    asm volatile("" ::: "memory");
#pragma unroll
                    for (int i = 0; i < 8; ++i) { const f32x4 x0 = xg[2 * i], x1 = xg[2 * i + 1];
                        u32x4 o; o.x = cvtpk(x0[0] * wg, x0[1] * wg); o.y = cvtpk(x0[2] * wg, x0[3] * wg); o.z = cvtpk(x1[0] * wg, x1[1] * wg); o.w = cvtpk(x1[2] * wg, x1[3] * wg);
                        *(u32x4*)(dst + 8 * i) = o; }
                }
            }
            __syncthreads();
        }
    } else {
        const int nb = G - GP;
        for (int u = ((int)blockIdx.x - GP) * 8 + wave; u < 1024; u += nb * 8) attn_sample_unit(a, lds, u, lane, wave);
    }
}

#define XB_TMO      128
#define XB_XCNT(j)  (256  + 64 * (j))
#define XB_XSUB(j)  (1280 + 64 * (j))
#define XB_XGEN(j)  (2304 + 64 * (j))
#define XB_TOP      3328
#define XB_TOPGEN   3392
#define XCD_BAR_WORDS 3456
#define XB_SPIN_CAP (1u << 18)

__device__ __forceinline__ unsigned xb_ld(unsigned* p)              { return __hip_atomic_load(p, __ATOMIC_RELAXED, __HIP_MEMORY_SCOPE_AGENT); }
__device__ __forceinline__ unsigned xb_add(unsigned* p, unsigned v) { return __hip_atomic_fetch_add(p, v, __ATOMIC_RELAXED, __HIP_MEMORY_SCOPE_AGENT); }
__device__ __forceinline__ unsigned xb_xcc_id() { return (unsigned)__builtin_amdgcn_s_getreg((3 << 11) | 20) & 0xFu; }
#define XB_SPIN(cond, bar) do { unsigned _sp = 0; while (cond) { __builtin_amdgcn_s_sleep(1); \
    if ((++_sp & 255u) == 0u) { if (xb_ld(&(bar)[XB_TMO])) break; if (_sp > XB_SPIN_CAP) { atomicAdd(&(bar)[XB_TMO], 1u); break; } } } } while (0)

struct XcdBarrier {
    unsigned* bar; unsigned x;
    volatile LAS unsigned* st;
};

__device__ __forceinline__ XcdBarrier xcd_barrier_post(unsigned* bar, volatile LAS unsigned* st) {
    XcdBarrier b; b.bar = bar; b.x = xb_xcc_id(); b.st = st;
    if (threadIdx.x == 0) (void)xb_add(&bar[XB_XCNT(b.x)], 1u);
    return b;
}
__device__ __forceinline__ void xcd_barrier_complete(unsigned* bar, unsigned x, unsigned& nloc, unsigned& nx) {
    const unsigned G = gridDim.x * gridDim.y * gridDim.z;
    unsigned sum, cnt, mine, sp = 0u;
    for (;;) {
        sum = 0u; cnt = 0u; mine = 0u;
#pragma unroll
        for (unsigned j = 0; j < 16; ++j) { const unsigned c = xb_ld(&bar[XB_XCNT(j)]); sum += c; cnt += (c > 0u) ? 1u : 0u; mine = (j == x) ? c : mine; }
        if (sum == G) break;
        __builtin_amdgcn_s_sleep(1);
        if ((++sp & 255u) == 0u) { if (xb_ld(&bar[XB_TMO])) break; if (sp > XB_SPIN_CAP) { atomicAdd(&bar[XB_TMO], 1u); break; } }
    }
    nloc = mine > 0u ? mine : 1u; nx = cnt > 0u ? cnt : 1u;
}

__device__ __forceinline__ void xcd_barrier(const XcdBarrier& b) {
    asm volatile("s_waitcnt vmcnt(0)" ::: "memory");
    __syncthreads();
    if (threadIdx.x == 0) {
        unsigned* bar = b.bar;
        __builtin_amdgcn_s_waitcnt(0);
        unsigned nloc = b.st[0], nx = b.st[1];
        if (nloc == 0u) { xcd_barrier_complete(bar, b.x, nloc, nx); b.st[0] = nloc; b.st[1] = nx; }
        const unsigned old = xb_add(&bar[XB_XSUB(b.x)], 1u);
        const unsigned gen = old / nloc;
        if (old + 1u == (gen + 1u) * nloc) {
            __builtin_amdgcn_fence(__ATOMIC_RELEASE, "agent");
            asm volatile("s_waitcnt vmcnt(0)" ::: "memory");
            const unsigned og = xb_add(&bar[XB_TOP], 1u);
            const unsigned tg = og / nx;
            if (og + 1u == (tg + 1u) * nx) xb_add(&bar[XB_TOPGEN], 1u);
            else XB_SPIN(xb_ld(&bar[XB_TOPGEN]) == tg, bar);
            __builtin_amdgcn_fence(__ATOMIC_ACQUIRE, "agent");
            xb_add(&bar[XB_XGEN(b.x)], 1u);
            asm volatile("s_waitcnt vmcnt(0)" ::: "memory");
        } else {
            XB_SPIN(xb_ld(&bar[XB_XGEN(b.x)]) == gen, bar);
            __builtin_amdgcn_fence(__ATOMIC_ACQUIRE, "agent");
            asm volatile("s_waitcnt vmcnt(0)" ::: "memory");
        }
    }
    __syncthreads();
}

template <int ns> DI float finalize_row(float* __restrict__ xr, const float* __restrict__ pr, bf16* __restrict__ xb, float scale, bool last) {
    float ss = 0.f;
#pragma unroll 1
    for (int j0 = 0; j0 < 32; j0 += 4) {
        f32x4 pv[4][ns], xv[4];
#pragma unroll
        for (int jj = 0; jj < 4; ++jj) {
#pragma unroll
            for (int s = 0; s < ns; ++s) pv[jj][s] = *(const f32x4*)(pr + (size_t)s * 256 * D + 4 * (j0 + jj));
            xv[jj] = *(const f32x4*)(xr + 4 * (j0 + jj));
        }
#pragma unroll
        for (int jj = 0; jj < 4; ++jj) {
            f32x4 s4 = pv[jj][0];
#pragma unroll
            for (int s = 1; s < ns; ++s) s4 += pv[jj][s];
            const f32x4 v = xv[jj] + s4 * scale;
            *(f32x4*)(xr + 4 * (j0 + jj)) = v;
            ss += (v[0] * v[0] + v[1] * v[1]) + (v[2] * v[2] + v[3] * v[3]);
            if (!last) { u32x2 w; w.x = cvtpk(v[0], v[1]); w.y = cvtpk(v[2], v[3]); *(u32x2*)(xb + 4 * (j0 + jj)) = w; }
        }
    }
    return ss;
}
template <int ns> DI void sample_finalize(const Args& a, LAS unsigned char* lds, unsigned* cnt, int pn, float scale, int slot, bool last, int tid) {
    volatile LAS unsigned* flag = (volatile LAS unsigned*)(lds + LDS_BYTES - 32);
    asm volatile("s_waitcnt vmcnt(0)" ::: "memory");
    __syncthreads();
    if (tid == 0) {
        __builtin_amdgcn_fence(__ATOMIC_RELEASE, "agent");
        asm volatile("s_waitcnt vmcnt(0)" ::: "memory");
        const unsigned old = __hip_atomic_fetch_add(cnt, 1u, __ATOMIC_RELAXED, __HIP_MEMORY_SCOPE_AGENT);
        flag[0] = (old + 1u == (unsigned)ns) ? 1u : 0u;
        __builtin_amdgcn_fence(__ATOMIC_ACQUIRE, "agent");
        asm volatile("s_waitcnt vmcnt(0)" ::: "memory");
    }
    __syncthreads();
    if (flag[0]) {
        const float* PART = (const float*)(a.ws + WS_U2 + 40 * MiB);
        float* ssq = (float*)(a.ws + WS_SSQ) + (size_t)slot * M;
        bf16* XBp = (bf16*)(a.ws + WS_XB);
        const int row = tid >> 1, c0 = pn * 256 + (tid & 1) * 128;
        const float ss0 = finalize_row<ns>(a.out + (size_t)(MP + row) * D + c0, PART + (size_t)row * D + c0, XBp + (size_t)(MP + row) * D + c0, scale, last);
        float ss = ss0;
        ss += __shfl_xor(ss, 1);
        if (!last && (tid & 1) == 0) atomicAdd(ssq + MP + row, ss);
    }
    __syncthreads();
}

__global__ void __launch_bounds__(512, 2) mk_fwd(Args a) {
    extern __shared__ __attribute__((aligned(16))) unsigned char lds_raw[];
    LAS unsigned char* lds = (LAS unsigned char*)lds_raw;
    cg::grid_group grid = cg::this_grid();
    const int tid = threadIdx.x, lane = tid & 63, wave = __builtin_amdgcn_readfirstlane(tid >> 6);
    unsigned char* ws = a.ws;
    const int lo = a.ph_lo, hi = a.ph_hi, G = gridDim.x, bx = blockIdx.x;
    float* ssq = (float*)(ws + WS_SSQ);
    volatile LAS unsigned* bst = (volatile LAS unsigned*)(lds + LDS_BYTES - 64);
    if (tid < 2) bst[tid] = 0u;
    __syncthreads();
    const XcdBarrier xbar = xcd_barrier_post((unsigned*)(ws + WS_BAR), bst);
    bf16* XB = (bf16*)(ws + WS_XB);
    bf16* ACT = (bf16*)(ws + WS_U1);
#define IN(k) (lo <= (k) && (k) < hi)
#define SEAM(k) do { if (IN(k) && IN((k) + 1)) { if (a.ph_lo < 0) grid.sync(); xcd_barrier(xbar); } } while (0)
#define GEMM_M(EpiT, E, Aptr, Bptr, M_, N_, K_, cidx) do { pg8::Gemm g_{(const pg8::bf16_t*)(Aptr), (const pg8::bf16_t*)(Bptr), (M_), (N_), (K_), (K_)}; pg8::StaticOrder S_; S_.init((M_), (N_), G, (cidx)); \
        pg8::gemm_phase<EpiT, pg8::StaticOrder, true, true>(lds, g_, S_, E); } while (0)
#define GEMM(EpiT, E, Aptr, Bptr, N_, K_, cidx) GEMM_M(EpiT, E, Aptr, Bptr, M, N_, K_, cidx)
#define RESID_GEMM(Aptr, Bptr, K_, NS_, scale_, slot_, last_, cw_) do { \
        if (G == 256) { \
            { EpiResid E_{a.out, (last_) ? nullptr : XB, (last_) ? nullptr : ssq + (slot_) * M, (scale_)}; GEMM_M(EpiResid, E_, Aptr, Bptr, MP, D, K_, bx); } \
            if (bx < 4 * (NS_)) { \
                { pg8::Gemm g_{(const pg8::bf16_t*)(Aptr), (const pg8::bf16_t*)(Bptr), M, D, (K_) / (NS_), (K_)}; SplitOrder S_{(NS_), (K_) / (NS_), bx}; EpiPartial E_{(float*)(ws + WS_U2 + 40 * MiB), (K_) / (NS_)}; \
                  pg8::gemm_phase<EpiPartial, SplitOrder, true, true>(lds, g_, S_, E_); } \
                sample_finalize<(NS_)>(a, lds, (unsigned*)(ws + WS_BAR) + 4096 + 64 * ((cw_) * 4 + (bx & 3)), bx & 3, (scale_), (slot_), (last_), tid); \
            } \
        } else { EpiResid E_{a.out, (last_) ? nullptr : XB, (last_) ? nullptr : ssq + (slot_) * M, (scale_)}; GEMM(EpiResid, E_, Aptr, Bptr, D, K_, bx); } \
    } while (0)
#define FFN_IN(mi, slot) do { EpiSwiGLU E_{ACT, ssq + (slot) * M}; GEMM(EpiSwiGLU, E_, XB, (bf16*)(ws + W_FI) + (size_t)(mi) * 2 * FF * D, 2 * FF, D, bx); } while (0)
#define FFN_OUT(mi, slot, last) do { EpiResid E_{a.out, (last) ? nullptr : XB, (last) ? nullptr : ssq + (slot) * M, 0.5f}; GEMM(EpiResid, E_, ACT, (bf16*)(ws + W_FO) + (size_t)(mi) * D * FF, D, FF, bx); } while (0)

    if (IN(0)) { p0_prologue(a, lds, tid, lane, wave); __syncthreads(); } SEAM(0);
    if (IN(1)) { FFN_IN(0, 0); } SEAM(1);
    if (IN(2)) { FFN_OUT(0, 1, false); } SEAM(2);
    if (IN(3)) { EpiScale E_{(bf16*)(ws + WS_U1), nullptr, NGLA, ssq + 1 * M}; GEMM(EpiScale, E_, XB, ws + W_GI, NGLA, D, bx); } SEAM(3);
    if (IN(4)) { gla_prep(a, lds, tid, lane, wave); } SEAM(4);
    if (IN(5)) { gla_rec(a, lds, tid, lane, wave); } SEAM(5);
    if (IN(6)) { EpiResid E_{a.out, XB, ssq + 2 * M, 1.0f}; GEMM(EpiResid, E_, ws + WS_U3, ws + W_GO, D, D, bx); } SEAM(6);
    if (IN(7)) { FFN_IN(1, 2); } SEAM(7);
    if (IN(8)) { FFN_OUT(1, 3, false); } SEAM(8);
    if (IN(9)) {
        { EpiScale E_{nullptr, (float*)(ws + WS_U2), 512, ssq + 3 * M}; GEMM(EpiScale, E_, XB, ws + W_KV, 512, D, bx); }
        { EpiSwiGLU E_{ACT, ssq + 3 * M}; GEMM(EpiSwiGLU, E_, XB, (bf16*)(ws + W_FI) + (size_t)2 * 2 * FF * D, 2 * FF, D, (G == 256) ? ((bx + 120) & 255) : bx); }
    } SEAM(9);
    if (IN(10)) {
        FFN_OUT(2, 4, false);
        if (G > 8) { if (bx >= 4) for (int it = bx - 4; it < M / 64; it += G - 4) kv_post_item(a, it, tid); }
        else for (int it = bx; it < M / 64; it += G) kv_post_item(a, it, tid);
    } SEAM(10);
    if (IN(11)) { EpiScale E_{(bf16*)(ws + WS_U1), nullptr, 768, ssq + 4 * M}; GEMM(EpiScale, E_, XB, ws + W_Q, 768, D, bx); } SEAM(11);
    if (IN(12)) { attn_phase(a, lds, tid, lane, wave); } SEAM(12);
    if (IN(13)) { EpiResid E_{a.out, XB, ssq + 5 * M, 1.0f}; GEMM(EpiResid, E_, ws + WS_U1 + 32 * MiB, ws + W_AO, D, 768, bx); } SEAM(13);
    if (IN(14)) { FFN_IN(3, 5); } SEAM(14);
    if (IN(15)) { FFN_OUT(3, 0, true); }
}

extern "C" void kernel_launch(void* const* d_in, const int* in_sizes, int n_in, void* d_out, int out_size, void* d_ws, size_t ws_size, hipStream_t stream) {
    static int grid = 0;
    if (grid == 0) {
        if (n_in != 19 || ws_size < WS_END) { fprintf(stderr, "kernel_launch: expected 19 inputs and >= %zu bytes of workspace (got %d, %zu)\n", (size_t)WS_END, n_in, ws_size); grid = -1; return; }
        int dev = 0, cus = 0, per_cu = 0;
        (void)hipGetDevice(&dev); (void)hipDeviceGetAttribute(&cus, hipDeviceAttributeMultiprocessorCount, dev);
        if (hipFuncSetAttribute((const void*)mk_fwd, hipFuncAttributeMaxDynamicSharedMemorySize, LDS_BYTES) != hipSuccess) { fprintf(stderr, "kernel_launch: hipFuncSetAttribute failed\n"); grid = -1; return; }
        if (hipOccupancyMaxActiveBlocksPerMultiprocessor(&per_cu, (const void*)mk_fwd, 512, LDS_BYTES) != hipSuccess || per_cu < 1) { fprintf(stderr, "kernel_launch: occupancy query failed (%d)\n", per_cu); per_cu = 1; }
        (void)hipGetLastError();
        grid = cus * (per_cu > 1 ? 1 : per_cu);
        if (grid <= 0) grid = 256;
    }
    if (grid < 0) return;
    (void)hipMemsetAsync((unsigned char*)d_ws + WS_BAR, 0, 32768, stream);
    Args a{};
    for (int i = 0; i < 19; ++i) a.in[i] = (const float*)d_in[i];
    a.out = (float*)d_out; a.ws = (unsigned char*)d_ws;
#if MK_PER_PHASE
    for (int p = 0; p < NPHASE; ++p) { a.ph_lo = p; a.ph_hi = p + 1; hipLaunchKernelGGL(mk_fwd, dim3(grid), dim3(512), LDS_BYTES, stream, a); }
#else
    a.ph_lo = 0; a.ph_hi = NPHASE;
    void* args[] = {&a};
    hipError_t e = hipLaunchCooperativeKernel((const void*)mk_fwd, dim3(grid), dim3(512), args, LDS_BYTES, stream);
    if (e != hipSuccess) fprintf(stderr, "kernel_launch: cooperative launch failed: %s (grid %d)\n", hipGetErrorString(e), grid);
#endif
}
```
